# Optimizing an MI355X kernel written in HIP

```python
import math
import jax
import jax.numpy as jnp
from jax import lax
import numpy as np

D_MODEL = 1024
BATCH = 8
SEQ = 2048
DEPTH = 2

CTX_LEN = 256
GRID_W = 64
D_MIX = D_MODEL
HY_WIDTH = D_MIX // 4
HY_GROUPS = 4
HY_SHORT = 3
HY_POS_DIM = 33
HY_FFN = 64
HY_FAST_DECAY = 0.3
HY_SLOW_DECAY = 1.5
HY_TARGET = 1e-2
ML_WIDTH = D_MIX // 2
ML_HEADS = 4
ML_HEAD_DIM = ML_WIDTH // ML_HEADS
ML_CONV = 4
ML_CHUNK = 128
RG_WIDTH = D_MIX - HY_WIDTH - ML_WIDTH
RG_HEADS = 4
RG_BLOCK = RG_WIDTH // RG_HEADS
RG_CONV = 4
RG_C = 8.0
D_FF = 4 * D_MODEL
N_MOD = 6
EPS = 1e-6
HY_COLS = 3 * HY_WIDTH
ML_GATE_COLS = 4 * ML_HEADS
ML_COLS = 4 * ML_WIDTH + ML_GATE_COLS
RG_COLS = 2 * RG_WIDTH
P_IN = HY_COLS + ML_COLS + RG_COLS
OFF_ML = HY_COLS
OFF_RG = HY_COLS + ML_COLS

kernel_name = 'hybrid_hyena_mlstm_rglru_dit'


def rmsnorm(x, g):
    xf = x.astype(jnp.float32)
    y = xf * lax.rsqrt(jnp.mean(xf * xf, axis=-1, keepdims=True) + EPS)
    return (y * g.astype(jnp.float32)).astype(x.dtype)


def head_rmsnorm(y, n_heads, g):
    shp = y.shape
    yf = y.astype(jnp.float32).reshape(shp[:-1] + (n_heads, shp[-1] // n_heads))
    yf = yf * lax.rsqrt(jnp.mean(yf * yf, axis=-1, keepdims=True) + EPS)
    return yf.reshape(shp) * g.astype(jnp.float32)


def dwconv(x, w):
    K = w.shape[0]
    pl = (K - 1) // 2
    return lax.conv_general_dilated(
        x, w[:, None, :].astype(x.dtype), window_strides=(1,), padding=[(pl, K - 1 - pl)],
        dimension_numbers=('NWC', 'WIO', 'NWC'), feature_group_count=x.shape[-1])


def to_col_major(a, rows):
    B, T, C = a.shape
    return a.reshape(B, rows, GRID_W, C).transpose(0, 2, 1, 3).reshape(B, T, C)


def from_col_major(a, rows):
    B, T, C = a.shape
    return a.reshape(B, GRID_W, rows, C).transpose(0, 2, 1, 3).reshape(B, T, C)


def hyena_filters(L, w1, b1, w2, b2, w3, b3, freq):
    f32 = jnp.float32
    pos = jnp.arange(L, dtype=f32)[:, None]
    t = pos / max(L - 1, 1)
    bands = (HY_POS_DIM - 1) // 2
    fr = jnp.linspace(1e-4, bands - 1, bands, dtype=f32)[None]
    ang = (2.0 * math.pi / L) * fr * pos
    feats = jnp.concatenate([t, jnp.cos(ang), -jnp.sin(ang)], axis=-1)
    fq = freq.astype(f32)
    h = jnp.sin(fq[0] * (feats @ w1.astype(f32) + b1.astype(f32)))
    h = jnp.sin(fq[1] * (h @ w2.astype(f32) + b2.astype(f32)))
    h = (h @ w3.astype(f32) + b3.astype(f32)).reshape(L, 2, HY_WIDTH)
    max_decay = math.log(HY_TARGET) / HY_FAST_DECAY
    min_decay = math.log(HY_TARGET) / HY_SLOW_DECAY
    deltas = jnp.linspace(min_decay, max_decay, HY_WIDTH, dtype=f32)
    h = h * jnp.exp(-t * jnp.abs(deltas))[:, None, :]
    h_fwd, h_bwd = h[:, 0], h[:, 1]
    return jnp.concatenate([h_fwd, jnp.zeros((1, HY_WIDTH), f32), h_bwd[:0:-1]], axis=0)


def hyena_longconv(u, filt, bias):
    L = u.shape[1]
    uf = u.astype(jnp.float32)
    U = jnp.fft.rfft(uf, n=2 * L, axis=1)
    F = jnp.fft.rfft(filt, n=2 * L, axis=0)
    y = jnp.fft.irfft(U * F[None], n=2 * L, axis=1)[:, :L]
    return y + uf * bias.astype(jnp.float32)


def hyena_group(z, p):
    L = z.shape[1]
    z = dwconv(z, p['hy_conv'])
    x0, x1, v = jnp.split(z, 3, axis=-1)
    filt = hyena_filters(L, p['hy_w1'], p['hy_b1'], p['hy_w2'], p['hy_b2'],
                         p['hy_w3'], p['hy_b3'], p['hy_freq'])
    return x0.astype(jnp.float32) * hyena_longconv(x1 * v, filt, p['hy_bias'])


def mlstm_prep(z, p):
    B, T, _ = z.shape
    f32 = jnp.float32
    qk = jax.nn.silu(dwconv(z[..., :2 * ML_WIDTH], p['ml_conv']))
    heads = lambda a: a.astype(f32).reshape(B, T, ML_HEADS, ML_HEAD_DIM).transpose(0, 2, 1, 3)
    q = heads(qk[..., :ML_WIDTH])
    k = heads(qk[..., ML_WIDTH:]) * (ML_HEAD_DIM ** -0.5)
    v = heads(z[..., 2 * ML_WIDTH:3 * ML_WIDTH])
    gates = z[..., 4 * ML_WIDTH:].astype(f32) + p['ml_gate_b'].astype(f32)
    gates = gates.reshape(B, T, 4, ML_HEADS).transpose(2, 0, 3, 1)
    return q, k, v, gates[0::2], jax.nn.log_sigmoid(gates[1::2])


def mlstm_scan(q, k, v, log_i, log_f, state, need_out):
    B, H, T, DH = q.shape
    N = T // ML_CHUNK
    ch = lambda a: a.reshape(a.shape[:2] + (N, ML_CHUNK) + a.shape[3:])
    q, k, v, li, lf = ch(q), ch(k), ch(v), ch(log_i), ch(log_f)
    b = jnp.cumsum(lf, axis=-1)
    g = b[..., -1:] - b + li
    m_loc = jnp.max(g, axis=-1)
    w = jnp.exp(g - m_loc[..., None])
    C_loc = jnp.einsum('bhnl,bhnld,bhnle->bhnde', w, v, k)
    n_loc = jnp.einsum('bhnl,bhnle->bhne', w, k)

    def step(carry, inp):
        C, n, m = carry
        b_last, ml, Cl, nl = inp
        m_new = jnp.maximum(b_last + m, ml)
        a = jnp.exp(b_last + m - m_new)
        s = jnp.exp(ml - m_new)
        C_new = a[..., None, None] * C + s[..., None, None] * Cl
        n_new = a[..., None] * n + s[..., None] * nl
        return (C_new, n_new, m_new), (C, n, m)

    mv = lambda a: jnp.moveaxis(a, 2, 0)
    final, starts = lax.scan(step, state, (mv(b[..., -1]), mv(m_loc), mv(C_loc), mv(n_loc)))
    if not need_out:
        return None, final
    C0, n0, m0 = [jnp.moveaxis(a, 0, 2) for a in starts]
    causal = jnp.tril(jnp.ones((ML_CHUNK, ML_CHUNK), dtype=bool))
    D = jnp.where(causal, b[..., :, None] - b[..., None, :] + li[..., None, :], -jnp.inf)
    inter = b + m0[..., None]
    m = jnp.maximum(inter, jnp.max(D, axis=-1))
    S = jnp.einsum('bhntd,bhnsd->bhnts', q, k) * jnp.exp(D - m[..., None])
    wi = jnp.exp(inter - m)
    num = jnp.einsum('bhnts,bhnsd->bhntd', S, v) + wi[..., None] * jnp.einsum('bhnde,bhnte->bhntd', C0, q)
    den = jnp.sum(S, axis=-1) + wi * jnp.einsum('bhne,bhnte->bhnt', n0, q)
    h = num / jnp.maximum(jnp.abs(den), jnp.exp(-m))[..., None]
    return h.reshape(B, H, T, DH), final


def mlstm_dirs(q, k, v, log_i, log_f, states, need_out):
    rev = lambda a: jnp.flip(a, axis=2)
    h_f, s_f = mlstm_scan(q, k, v, log_i[0], log_f[0], states[0], need_out)
    h_b, s_b = mlstm_scan(rev(q), rev(k), rev(v), rev(log_i[1]), rev(log_f[1]), states[1], need_out)
    h = h_f + rev(h_b) if need_out else None
    return h, (s_f, s_b)


def heads_to_tokens(h):
    B, H, T, DH = h.shape
    return h.transpose(0, 2, 1, 3).reshape(B, T, H * DH)


def rglru_prep(zx, p):
    B, T, _ = zx.shape
    f32 = jnp.float32
    xr = dwconv(zx, p['rg_conv']).astype(f32)
    pre = jnp.einsum('bthi,dghij->dgbthj', xr.reshape(B, T, RG_HEADS, RG_BLOCK),
                     p['rg_gate_w'].astype(f32)).reshape(2, 2, B, T, RG_WIDTH)
    pre = pre + p['rg_gate_b'].astype(f32)[:, :, None, None, :]
    r = jax.nn.sigmoid(pre[:, 0])
    i = jax.nn.sigmoid(pre[:, 1])
    log_a = -RG_C * r * jax.nn.softplus(-p['rg_lambda'].astype(f32))[:, None, None, :]
    a = jnp.exp(log_a)
    b = jnp.sqrt(-jnp.expm1(2.0 * log_a)) * (i * xr[None])
    return a, b


def linear_scan(a, b, h0):
    def comb(l, r):
        return l[0] * r[0], r[0] * l[1] + r[1]
    A, Hs = lax.associative_scan(comb, (a, b), axis=1)
    return A * h0[:, None] + Hs


def rglru_dirs(a, b, h0s):
    h_f = linear_scan(a[0], b[0], h0s[0])
    h_b = jnp.flip(linear_scan(jnp.flip(a[1], 1), jnp.flip(b[1], 1), h0s[1]), 1)
    return h_f + h_b, (h_f[:, -1], h_b[:, 0])


def merge_groups(y_hy, h_ml, o_pre, h_rg, gate_pre, p, dt):
    g = p['mix_norm_g']
    y_hy = head_rmsnorm(y_hy, HY_GROUPS, g[:HY_WIDTH])
    y_ml = head_rmsnorm(h_ml, ML_HEADS, g[HY_WIDTH:HY_WIDTH + ML_WIDTH]) * jax.nn.sigmoid(o_pre.astype(jnp.float32))
    y_rg = head_rmsnorm(h_rg * jax.nn.gelu(gate_pre.astype(jnp.float32)), RG_HEADS, g[HY_WIDTH + ML_WIDTH:])
    y = jnp.concatenate([y_hy, y_ml, y_rg], axis=-1).astype(dt)
    return y @ p['w_out']


def token_mixer(h_ctx, h_lat, p, rows, need_ctx_out):
    B = h_lat.shape[0]
    f32 = jnp.float32
    z_ctx = h_ctx @ p['w_in']
    z_lat = h_lat @ p['w_in']
    ml_zero = (jnp.zeros((B, ML_HEADS, ML_HEAD_DIM, ML_HEAD_DIM), f32),
               jnp.zeros((B, ML_HEADS, ML_HEAD_DIM), f32), jnp.zeros((B, ML_HEADS), f32))
    rg_zero = jnp.zeros((B, RG_WIDTH), f32)
    cq, ck, cv, cli, clf = mlstm_prep(z_ctx[..., OFF_ML:OFF_RG], p)
    hm_c, ml_states = mlstm_dirs(cq, ck, cv, cli, clf, (ml_zero, ml_zero), need_ctx_out)
    ca, cb = rglru_prep(z_ctx[..., OFF_RG:OFF_RG + RG_WIDTH], p)
    hr_c, rg_states = rglru_dirs(ca, cb, (rg_zero, rg_zero))
    y_ctx = None
    if need_ctx_out:
        y_hy_c = hyena_group(z_ctx[..., :HY_COLS], p)
        y_ctx = merge_groups(y_hy_c, heads_to_tokens(hm_c),
                             z_ctx[..., OFF_ML + 3 * ML_WIDTH:OFF_ML + 4 * ML_WIDTH],
                             hr_c, z_ctx[..., OFF_RG + RG_WIDTH:], p, h_ctx.dtype)
    y_hy = hyena_group(z_lat[..., :HY_COLS], p)
    lq, lk, lv, lli, llf = mlstm_prep(to_col_major(z_lat[..., OFF_ML:OFF_RG], rows), p)
    hm, _ = mlstm_dirs(lq, lk, lv, lli, llf, ml_states, True)
    hm = from_col_major(heads_to_tokens(hm), rows)
    la, lb = rglru_prep(z_lat[..., OFF_RG:OFF_RG + RG_WIDTH], p)
    hr, _ = rglru_dirs(la, lb, rg_states)
    y_lat = merge_groups(y_hy, hm, z_lat[..., OFF_ML + 3 * ML_WIDTH:OFF_ML + 4 * ML_WIDTH],
                         hr, z_lat[..., OFF_RG + RG_WIDTH:], p, h_lat.dtype)
    return y_ctx, y_lat


def sq_relu_mlp(h, w1, w2):
    return jnp.square(jax.nn.relu(h @ w1)) @ w2


def modulate(t, g, m, i):
    return rmsnorm(t, g) * (1.0 + m[:, :, i + 1]) + m[:, :, i]


def setup_inputs(seed: int = 0) -> dict:
    key = jax.random.key(seed)
    ks = jax.random.split(key, 32)

    def nrm(k, shape, scale):
        return jax.random.normal(k, shape, jnp.float32) * scale

    x = nrm(ks[0], (BATCH, SEQ, D_MODEL), 1.0)
    c = nrm(ks[1], (BATCH, D_MODEL), 1.0)
    ctx = nrm(ks[2], (BATCH, CTX_LEN, D_MODEL), 1.0)
    c_ctx = nrm(ks[3], (D_MODEL,), 1.0)
    ada_w = nrm(ks[4], (DEPTH, D_MODEL, N_MOD * D_MODEL), D_MODEL ** -0.5)
    ada_b = nrm(ks[5], (DEPTH, N_MOD * D_MODEL), 0.02)
    norm1_g = 1.0 + nrm(ks[6], (DEPTH, D_MODEL), 0.02)
    norm2_g = 1.0 + nrm(ks[7], (DEPTH, D_MODEL), 0.02)
    w_in = nrm(ks[8], (DEPTH, D_MODEL, P_IN), D_MODEL ** -0.5)
    hy_conv = nrm(ks[9], (DEPTH, HY_SHORT, HY_COLS), HY_SHORT ** -0.5)
    hy_w1 = nrm(ks[10], (DEPTH, HY_POS_DIM, HY_FFN), HY_POS_DIM ** -0.5)
    hy_b1 = nrm(ks[11], (DEPTH, HY_FFN), 0.02)
    hy_w2 = nrm(ks[12], (DEPTH, HY_FFN, HY_FFN), HY_FFN ** -0.5)
    hy_b2 = nrm(ks[13], (DEPTH, HY_FFN), 0.02)
    hy_w3 = nrm(ks[14], (DEPTH, HY_FFN, 2 * HY_WIDTH), HY_FFN ** -0.5)
    hy_b3 = nrm(ks[15], (DEPTH, 2 * HY_WIDTH), 0.02)
    hy_freq = 1.0 + nrm(ks[16], (DEPTH, 2, HY_FFN), 0.02)
    hy_bias = nrm(ks[17], (DEPTH, HY_WIDTH), 1.0)
    ml_conv = nrm(ks[18], (DEPTH, ML_CONV, 2 * ML_WIDTH), ML_CONV ** -0.5)
    i_bias = nrm(ks[19], (DEPTH, 2, 1, ML_HEADS), 0.1)
    f_bias = jnp.linspace(3.0, 6.0, ML_HEADS, dtype=jnp.float32) + nrm(ks[20], (DEPTH, 2, 1, ML_HEADS), 0.1)
    ml_gate_b = jnp.concatenate([i_bias, f_bias], axis=2).reshape(DEPTH, ML_GATE_COLS)
    rg_conv = nrm(ks[21], (DEPTH, RG_CONV, RG_WIDTH), RG_CONV ** -0.5)
    rg_gate_w = nrm(ks[22], (DEPTH, 2, 2, RG_HEADS, RG_BLOCK, RG_BLOCK), RG_BLOCK ** -0.5)
    rg_gate_b = nrm(ks[23], (DEPTH, 2, 2, RG_WIDTH), 0.02)
    a_c = jax.random.uniform(ks[24], (DEPTH, 2, RG_WIDTH), jnp.float32, 0.9, 0.999)
    s = a_c ** (1.0 / RG_C)
    rg_lambda = jnp.log(s) - jnp.log1p(-s)
    mix_norm_g = 1.0 + nrm(ks[25], (DEPTH, D_MIX), 0.02)
    w_out = nrm(ks[26], (DEPTH, D_MIX, D_MODEL), D_MIX ** -0.5)
    mlp_w1 = nrm(ks[27], (DEPTH, D_MODEL, D_FF), D_MODEL ** -0.5)
    mlp_w2 = nrm(ks[28], (DEPTH, D_FF, D_MODEL), D_FF ** -0.5)
    final_g = 1.0 + nrm(ks[29], (D_MODEL,), 0.02)
    return {'x': x, 'c': c, 'ctx': ctx, 'c_ctx': c_ctx, 'ada_w': ada_w, 'ada_b': ada_b,
            'norm1_g': norm1_g, 'norm2_g': norm2_g, 'w_in': w_in, 'hy_conv': hy_conv,
            'hy_w1': hy_w1, 'hy_b1': hy_b1, 'hy_w2': hy_w2, 'hy_b2': hy_b2, 'hy_w3': hy_w3,
            'hy_b3': hy_b3, 'hy_freq': hy_freq, 'hy_bias': hy_bias, 'ml_conv': ml_conv,
            'ml_gate_b': ml_gate_b, 'rg_conv': rg_conv, 'rg_gate_w': rg_gate_w,
            'rg_gate_b': rg_gate_b, 'rg_lambda': rg_lambda, 'mix_norm_g': mix_norm_g,
            'w_out': w_out, 'mlp_w1': mlp_w1, 'mlp_w2': mlp_w2, 'final_g': final_g}


def reference(x, c, ctx, c_ctx, ada_w, ada_b, norm1_g, norm2_g, w_in, hy_conv,
              hy_w1, hy_b1, hy_w2, hy_b2, hy_w3, hy_b3, hy_freq, hy_bias, ml_conv,
              ml_gate_b, rg_conv, rg_gate_w, rg_gate_b, rg_lambda, mix_norm_g,
              w_out, mlp_w1, mlp_w2, final_g):
    B, T, D = x.shape
    rows = T // GRID_W
    ctx_s = ctx
    for l in range(DEPTH):
        need_ctx = l < DEPTH - 1
        p = {'w_in': w_in[l], 'w_out': w_out[l], 'hy_conv': hy_conv[l], 'hy_w1': hy_w1[l],
             'hy_b1': hy_b1[l], 'hy_w2': hy_w2[l], 'hy_b2': hy_b2[l], 'hy_w3': hy_w3[l],
             'hy_b3': hy_b3[l], 'hy_freq': hy_freq[l], 'hy_bias': hy_bias[l],
             'ml_conv': ml_conv[l], 'ml_gate_b': ml_gate_b[l], 'rg_conv': rg_conv[l],
             'rg_gate_w': rg_gate_w[l], 'rg_gate_b': rg_gate_b[l], 'rg_lambda': rg_lambda[l],
             'mix_norm_g': mix_norm_g[l]}
        mod = (jax.nn.silu(c) @ ada_w[l] + ada_b[l]).reshape(B, 1, N_MOD, D)
        mod_c = (jax.nn.silu(c_ctx) @ ada_w[l] + ada_b[l]).reshape(1, 1, N_MOD, D)
        hx = modulate(x, norm1_g[l], mod, 0)
        hc = modulate(ctx_s, norm1_g[l], mod_c, 0)
        y_ctx, y_lat = token_mixer(hc, hx, p, rows, need_ctx)
        x = x + mod[:, :, 2] * y_lat
        x = x + mod[:, :, 5] * sq_relu_mlp(modulate(x, norm2_g[l], mod, 3), mlp_w1[l], mlp_w2[l])
        if need_ctx:
            ctx_s = ctx_s + mod_c[:, :, 2] * y_ctx
            ctx_s = ctx_s + mod_c[:, :, 5] * sq_relu_mlp(modulate(ctx_s, norm2_g[l], mod_c, 3), mlp_w1[l], mlp_w2[l])
    return rmsnorm(x, final_g)
```

```cpp
#include <hip/hip_runtime.h>
#include <hip/hip_cooperative_groups.h>
#include <cstdio>
namespace cg = cooperative_groups;

typedef unsigned short bf16_t;
using bf16x8 = __attribute__((ext_vector_type(8))) short;
using f32x4 = __attribute__((ext_vector_type(4))) float;

#define NLAT 16384
#define NROW 18432
#define ZS 3328
#define LTOT 2304
#define EPSF 1e-6f

constexpr size_t MiB = 1048576;
constexpr size_t OFF_A = 0;
constexpr size_t OFF_YCV = 117 * MiB;
constexpr size_t OFF_ACT = 128 * MiB;
constexpr size_t OFF_ST = 164 * MiB;
constexpr size_t OFF_W = 200 * MiB;
constexpr size_t OFF_WIN = OFF_W;
constexpr size_t OFF_WOUT = OFF_WIN + (size_t)3328 * 1024 * 2;
constexpr size_t OFF_W1 = OFF_WOUT + 2 * MiB;
constexpr size_t OFF_W2 = OFF_W1 + 8 * MiB;
constexpr size_t OFF_CTXS = OFF_W2 + 8 * MiB;
constexpr size_t OFF_FILT = OFF_CTXS + 8 * MiB;
constexpr size_t OFF_G = OFF_FILT + 9 * MiB;
constexpr size_t OFF_MOD = OFF_G + (size_t)NROW * 16 * 4;
constexpr size_t OFF_NST = OFF_MOD + (size_t)2 * 9 * 6144 * 4;
constexpr size_t OFF_SCAL = OFF_NST + (size_t)1152 * 128 * 4;
constexpr size_t OFF_RGAGG = OFF_SCAL + 16384;
constexpr size_t OFF_RGCAR = OFF_RGAGG + (size_t)8 * 36 * 2 * 256 * 2 * 4;
constexpr size_t OFF_BAR = OFF_RGCAR + (size_t)8 * 36 * 2 * 256 * 4;
constexpr size_t OFF_RGW = OFF_BAR + 16384;
constexpr size_t OFF_END = OFF_RGW + (size_t)2 * 16 * 4096 * 2;
static_assert(OFF_END <= 256 * MiB, "workspace");

constexpr int LDS_XB = 149504;
constexpr int LDS_BYTES = 149504 + 16;
#define REP_P0 1
#define REP_NORM 1
#define REP_P2 1
#define REP_P3 1
#define REP_HYC 1
#define REP_P5 1
#define REP_P8 1
#define REP_SYNC 1
#define REP_ML 1
#define REP_RG 1
#define GSYNC() do { for (int rs_ = 0; rs_ < REP_SYNC; ++rs_) xcd_barrier(xb); } while (0)


struct Params {
  const float* in[29];
  float* out;
  unsigned char* ws;
};

__device__ __forceinline__ int opaque_tid() { int t = threadIdx.x; asm volatile("" : "+v"(t)); return t; }
typedef __bf16 hwbf16x2_t __attribute__((ext_vector_type(2)));
typedef float hwf32x2_t __attribute__((ext_vector_type(2)));
__device__ __forceinline__ unsigned pack2(float a, float b) {
  hwf32x2_t v = {a, b};
  hwbf16x2_t r = __builtin_convertvector(v, hwbf16x2_t);
  return __builtin_bit_cast(unsigned, r);
}
__device__ __forceinline__ bf16_t f2bf(float f) { return (bf16_t)(pack2(f, 0.f) & 0xffffu); }
__device__ __forceinline__ float bf2f(bf16_t h) { return __uint_as_float(((unsigned)h) << 16); }
__device__ __forceinline__ float lo16(unsigned u) { return __uint_as_float(u << 16); }
__device__ __forceinline__ float hi16(unsigned u) { return __uint_as_float(u & 0xffff0000u); }
__device__ __forceinline__ void unpack8(uint4 u, float* f) {
  f[0] = lo16(u.x); f[1] = hi16(u.x); f[2] = lo16(u.y); f[3] = hi16(u.y);
  f[4] = lo16(u.z); f[5] = hi16(u.z); f[6] = lo16(u.w); f[7] = hi16(u.w);
}
__device__ __forceinline__ uint4 pack8(const float* f) {
  uint4 u; u.x = pack2(f[0], f[1]); u.y = pack2(f[2], f[3]); u.z = pack2(f[4], f[5]); u.w = pack2(f[6], f[7]); return u;
}
__device__ __forceinline__ float shfl_idx(float v, int srclane) {
  return __builtin_bit_cast(float, __builtin_amdgcn_ds_bpermute(srclane << 2, __builtin_bit_cast(int, v)));
}
__device__ __forceinline__ float wsum(float v, int lane) {
#pragma unroll
  for (int o = 32; o > 0; o >>= 1) v += shfl_idx(v, lane ^ o);
  return v;
}
__device__ __forceinline__ float fexp(float x) { return __expf(x); }
__device__ __forceinline__ float frcp(float x) { return __builtin_amdgcn_rcpf(x); }
__device__ __forceinline__ float sigm(float x) { return frcp(1.f + fexp(-x)); }
__device__ __forceinline__ float siluf(float x) { return x * frcp(1.f + fexp(-x)); }
__device__ __forceinline__ float logsig(float x) { return fminf(x, 0.f) - __logf(1.f + fexp(-fabsf(x))); }
__device__ __forceinline__ float softplusf(float x) { return fmaxf(x, 0.f) + __logf(1.f + fexp(-fabsf(x))); }
__device__ __forceinline__ float gelu_tanh(float x) {
  const float u = 0.7978845608028654f * (x + 0.044715f * x * x * x);
  const float th = 1.f - 2.f * frcp(fexp(2.f * u) + 1.f);
  return 0.5f * x * (1.f + th);
}
__device__ __forceinline__ f32x4 mfma16(bf16x8 a, bf16x8 b, f32x4 c) {
  return __builtin_amdgcn_mfma_f32_16x16x32_bf16(a, b, c, 0, 0, 0);
}
__device__ __forceinline__ bf16x8 ldfrag(const bf16_t* p) { return *(const bf16x8*)p; }


#define XB_TMO      128
#define XB_XCNT(j)  (256  + 64 * (j))
#define XB_XSUB(j)  (1280 + 64 * (j))
#define XB_XGEN(j)  (2304 + 64 * (j))
#define XB_TOP      3328
#define XB_TOPGEN   3392
#define XCD_BAR_WORDS 3456
#define XB_SPIN_CAP (1u << 18)
#define LAS __attribute__((address_space(3)))
__device__ __forceinline__ unsigned xb_ld(unsigned* p)              { return __hip_atomic_load(p, __ATOMIC_RELAXED, __HIP_MEMORY_SCOPE_AGENT); }
__device__ __forceinline__ unsigned xb_add(unsigned* p, unsigned v) { return __hip_atomic_fetch_add(p, v, __ATOMIC_RELAXED, __HIP_MEMORY_SCOPE_AGENT); }
__device__ __forceinline__ unsigned xb_xcc_id() { return (unsigned)__builtin_amdgcn_s_getreg((3 << 11) | 20) & 0xFu; }
#define XB_SPIN(cond, bar) do { unsigned _sp = 0; while (cond) { __builtin_amdgcn_s_sleep(1); \
    if ((++_sp & 255u) == 0u) { if (xb_ld(&(bar)[XB_TMO])) break; if (_sp > XB_SPIN_CAP) { atomicAdd(&(bar)[XB_TMO], 1u); break; } } } } while (0)
struct XcdBarrier { unsigned* bar; unsigned x; volatile LAS unsigned* st; };
__device__ __forceinline__ XcdBarrier xcd_barrier_post(unsigned* bar, volatile LAS unsigned* st) {
    XcdBarrier b; b.bar = bar; b.x = xb_xcc_id(); b.st = st;
    if (threadIdx.x == 0) (void)xb_add(&bar[XB_XCNT(b.x)], 1u);
    return b;
}
__device__ __forceinline__ void xcd_barrier_complete(unsigned* bar, unsigned x, unsigned& nloc, unsigned& nx) {
    const unsigned G = gridDim.x * gridDim.y * gridDim.z;
    unsigned sum, cnt, mine, sp = 0u;
    for (;;) {
        sum = 0u; cnt = 0u; mine = 0u;
#pragma unroll
        for (unsigned j = 0; j < 16; ++j) { const unsigned c = xb_ld(&bar[XB_XCNT(j)]); sum += c; cnt += (c > 0u) ? 1u : 0u; mine = (j == x) ? c : mine; }
        if (sum == G) break;
        __builtin_amdgcn_s_sleep(1);
        if ((++sp & 255u) == 0u) { if (xb_ld(&bar[XB_TMO])) break; if (sp > XB_SPIN_CAP) { atomicAdd(&bar[XB_TMO], 1u); break; } }
    }
    nloc = mine > 0u ? mine : 1u; nx = cnt > 0u ? cnt : 1u;
}
__device__ __forceinline__ void xcd_barrier(const XcdBarrier& b) {
    asm volatile("s_waitcnt vmcnt(0)" ::: "memory");
    __syncthreads();
    if (threadIdx.x == 0) {
        unsigned* bar = b.bar;
        __builtin_amdgcn_s_waitcnt(0);
        unsigned nloc = b.st[0], nx = b.st[1];
        if (nloc == 0u) { xcd_barrier_complete(bar, b.x, nloc, nx); b.st[0] = nloc; b.st[1] = nx; }
        const unsigned old = xb_add(&bar[XB_XSUB(b.x)], 1u);
        const unsigned gen = old / nloc;
        if (old + 1u == (gen + 1u) * nloc) {
            __builtin_amdgcn_fence(__ATOMIC_RELEASE, "agent");
            asm volatile("s_waitcnt vmcnt(0)" ::: "memory");
            const unsigned og = xb_add(&bar[XB_TOP], 1u);
            const unsigned tg = og / nx;
            if (og + 1u == (tg + 1u) * nx) xb_add(&bar[XB_TOPGEN], 1u);
            else XB_SPIN(xb_ld(&bar[XB_TOPGEN]) == tg, bar);
            __builtin_amdgcn_fence(__ATOMIC_ACQUIRE, "agent");
            xb_add(&bar[XB_XGEN(b.x)], 1u);
            asm volatile("s_waitcnt vmcnt(0)" ::: "memory");
        } else {
            XB_SPIN(xb_ld(&bar[XB_XGEN(b.x)]) == gen, bar);
            __builtin_amdgcn_fence(__ATOMIC_ACQUIRE, "agent");
            asm volatile("s_waitcnt vmcnt(0)" ::: "memory");
        }
    }
    __syncthreads();
}

__device__ __forceinline__ int g8_lds_byte(int r, int c) {
  int st = (r >> 4) * 2 + (c >> 5), rr = r & 15, cc = c & 31, ob = rr * 64 + cc * 2;
  return st * 1024 + (ob ^ (((ob >> 9) & 1) << 5));
}
__device__ __forceinline__ void g8_stage_rc(int b, int& R, int& C) {
  int st = b / 1024, sb = b % 1024, swz = sb ^ (((sb >> 9) & 1) << 5);
  R = (st >> 1) * 16 + swz / 64; C = (st & 1) * 32 + (swz % 64) / 2;
}
struct GUnit { int brow, bcol, kst, nt, piece; };
template <class Epi>
__device__ __forceinline__ void gemm_phase(unsigned char* lds_g, const bf16_t* A0, const bf16_t* A1, int lda, const bf16_t* Bt, int K,
                           int mtiles, int ntiles, int ksplit, Epi epi) {
  (void)lda;
  constexpr int BK = 64, HALF = 128, HTB = HALF * BK * 2;
  constexpr bool G_SP2 = true, G_ALIGN = true;
  LAS unsigned char* lds = (LAS unsigned char*)lds_g;
  const int tid = opaque_tid(), wid = __builtin_amdgcn_readfirstlane(tid >> 6), lane = tid & 63, wr = wid >> 2, wc = wid & 3, fr = lane & 15, fq = lane >> 4;
  const int lat_items = (mtiles < 64 ? mtiles : 64) * ntiles;
  const int ntl = lat_items + (mtiles - (mtiles < 64 ? mtiles : 64)) * ntiles * ksplit;
  const int nt_all = K / BK;
  const int piece_steps = (ksplit == 1) ? nt_all : (((nt_all + ksplit - 1) / ksplit + 1) & ~1);
  const int G8 = gridDim.x >> 3;
  const int vb = ((gridDim.x & 7) == 0) ? ((blockIdx.x & 7) * G8 + (blockIdx.x >> 3)) : blockIdx.x;
  auto get_unit = [&](int i, GUnit& u) -> bool {
    if (ksplit == 1) {
      const int nwg = mtiles * ntiles, L = i * (int)gridDim.x + (int)blockIdx.x;
      if (L >= nwg) return false;
      int wgid = L; { const int q = nwg / 8, r = nwg % 8, xcd = wgid % 8, off = wgid / 8; wgid = (xcd < r ? xcd * (q + 1) : r * (q + 1) + (xcd - r) * q) + off; }
      const int nig = 8 * ntiles, gid = wgid / nig, fm = gid * 8, gsz = (mtiles - fm) < 8 ? (mtiles - fm) : 8;
      const int pm = fm + ((wgid % nig) % gsz), pn = (wgid % nig) / gsz;
      u.piece = 0; u.kst = 0; u.nt = nt_all; u.brow = pm * 256; u.bcol = pn * 256;
      return true;
    }
    const int item = (i == 0 ? vb : (int)blockIdx.x) + i * (int)gridDim.x;
    if (item >= ntl) return false;
    int tile = item; u.piece = 0;
    if (item >= lat_items) { const int c_ = item - lat_items; tile = lat_items + c_ / ksplit; u.piece = c_ - (c_ / ksplit) * ksplit; }
    u.kst = u.piece * piece_steps;
    u.nt = (item < lat_items) ? nt_all : ((nt_all - u.kst < piece_steps) ? (nt_all - u.kst) : piece_steps);
    const int pm = tile / ntiles, pn = tile - pm * ntiles;
    u.brow = pm * 256; u.bcol = pn * 256;
    return true;
  };
  unsigned voff[2], voffB[2];
#pragma unroll
  for (int i = 0; i < 2; ++i) {
    int R, C; g8_stage_rc(tid * 16 + i * 8192, R, C);
    const int rho = R & 31, Rb = (R & ~31) + 8 * ((rho & 15) >> 2) + 4 * (rho >> 4) + (rho & 3);
    voff[i] = (unsigned)(R * K + C) * 2u; voffB[i] = (unsigned)(Rb * K + C) * 2u;
  }
  const size_t kstep = (size_t)(BK * 2);
  const size_t hstep = (size_t)HALF * K * 2;
  const unsigned ldsw = (unsigned)wid * 1024u;
  const int aoff = g8_lds_byte(wr * 64 + fr, fq * 8), boff = g8_lds_byte(wc * 32 + fr, fq * 8);
#define PG8_SA(b, h) (((b) * 2 + (h)) * HTB)
#define PG8_SB(b, h) ((4 + (b) * 2 + (h)) * HTB)
#define PG8_STAGE_(bufoff, gbase, vo) do { _Pragma("unroll") for (int _i = 0; _i < 2; ++_i) \
        __builtin_amdgcn_global_load_lds((const unsigned*)((const char*)(gbase) + (vo)[_i]), (LAS unsigned*)(lds + (bufoff) + ldsw + _i * 8192), 16, 0, 0); } while (0)
#define PG8_STAGE(bufoff, gbase) PG8_STAGE_(bufoff, gbase, voff)
#define PG8_STAGEB(bufoff, gbase) PG8_STAGE_(bufoff, gbase, voffB)
#define PG8_LDA(dst, b, h) do { _Pragma("unroll") for (int m = 0; m < 4; ++m) _Pragma("unroll") for (int k = 0; k < 2; ++k) dst[m][k] = *(const LAS bf16x8*)(lds + PG8_SA(b, h) + aoff + m * 2048 + k * 1024); } while (0)
#define PG8_LDB(dst, b, h) do { _Pragma("unroll") for (int n = 0; n < 2; ++n) _Pragma("unroll") for (int k = 0; k < 2; ++k) dst[n][k] = *(const LAS bf16x8*)(lds + PG8_SB(b, h) + boff + n * 2048 + k * 1024); } while (0)
#define PG8_MMA(ai, bj, At, Bt_) do { __builtin_amdgcn_s_setprio(1); _Pragma("unroll") for (int m = 0; m < 4; ++m) _Pragma("unroll") for (int n = 0; n < 2; ++n) _Pragma("unroll") for (int k = 0; k < 2; ++k) \
        acc[ai][bj][m][n] = __builtin_amdgcn_mfma_f32_16x16x32_bf16(Bt_[n][k], At[m][k], acc[ai][bj][m][n], 0, 0, 0); __builtin_amdgcn_s_setprio(0); } while (0)
#define PG8_WAIT_V(n) asm volatile("s_waitcnt vmcnt(" #n ")" ::: "memory")
#define PG8_WAIT_L(n) asm volatile("s_waitcnt lgkmcnt(" #n ")" ::: "memory")
#define PG8_BAR __builtin_amdgcn_s_barrier()
#define PG8_SCHED __builtin_amdgcn_sched_barrier(0)
#define PG8_APTR(u) ((const char*)(((u).brow < NLAT) ? (A0 + (size_t)(u).brow * K) : (A1 + (size_t)((u).brow - NLAT) * K)) + (size_t)(u).kst * kstep)
#define PG8_BPTR(u) ((const char*)(Bt + (size_t)(u).bcol * K) + (size_t)(u).kst * kstep)
  GUnit cur, nxt; int ui = 0;
  if (get_unit(0, cur)) {
    f32x4 acc[2][2][4][2];
#pragma unroll
    for (int a = 0; a < 2; ++a)
#pragma unroll
      for (int b = 0; b < 2; ++b)
#pragma unroll
        for (int m = 0; m < 4; ++m)
#pragma unroll
          for (int n = 0; n < 2; ++n) acc[a][b][m][n] = (f32x4){0.f, 0.f, 0.f, 0.f};
    bf16x8 At[4][2], B0[2][2], B1[2][2];
    const char* cA = PG8_APTR(cur); const char* cB = PG8_BPTR(cur);
    if (G_SP2) {
      PG8_STAGEB(PG8_SB(0, 0), cB); PG8_STAGEB(PG8_SB(0, 1), cB + hstep); PG8_STAGE(PG8_SA(0, 0), cA); PG8_STAGE(PG8_SA(0, 1), cA + hstep);
      if (wr == 1) PG8_BAR;
      PG8_WAIT_V(2); PG8_BAR;
      PG8_STAGEB(PG8_SB(1, 0), cB + kstep); PG8_STAGE(PG8_SA(1, 0), cA + kstep); PG8_STAGEB(PG8_SB(1, 1), cB + hstep + kstep);
      PG8_WAIT_V(6); PG8_BAR;
    } else {
      PG8_STAGEB(PG8_SB(0, 0), cB); PG8_STAGE(PG8_SA(0, 0), cA); PG8_STAGEB(PG8_SB(0, 1), cB + hstep); PG8_STAGE(PG8_SA(0, 1), cA + hstep);
      if (wr == 1) PG8_BAR;
      PG8_WAIT_V(4); PG8_BAR;
      PG8_STAGEB(PG8_SB(1, 0), cB + kstep); PG8_STAGE(PG8_SA(1, 0), cA + kstep); PG8_STAGEB(PG8_SB(1, 1), cB + hstep + kstep);
      PG8_WAIT_V(6); PG8_BAR;
    }
    for (;;) {
      const bool has_next = get_unit(ui + 1, nxt);
      const char* nA = has_next ? PG8_APTR(nxt) : cA; const char* nB = has_next ? PG8_BPTR(nxt) : cB;
      const int nt = cur.nt;
      for (int t = 0; t < nt; t += 2) {
        const bool last = (t == nt - 2);
        const char* a1 = cA + (size_t)(t + 1) * kstep;
        const char* a2 = last ? nA : cA + (size_t)(t + 2) * kstep; const char* b2 = last ? nB : cB + (size_t)(t + 2) * kstep;
        const char* a3 = a2 + kstep; const char* b3 = b2 + kstep;
        if (G_SP2) {
        PG8_LDB(B0, 0, 0); PG8_LDB(B1, 0, 1); PG8_SCHED; PG8_LDA(At, 0, 0); PG8_STAGE(PG8_SA(1, 1), a1 + hstep);
        PG8_WAIT_V(8); PG8_WAIT_L(0); PG8_BAR; PG8_MMA(0, 0, At, B0); PG8_MMA(0, 1, At, B1); PG8_BAR; PG8_SCHED;
        PG8_LDA(At, 0, 1); PG8_STAGEB(PG8_SB(0, 0), b2); PG8_STAGEB(PG8_SB(0, 1), b2 + hstep); PG8_STAGE(PG8_SA(0, 0), a2);
        PG8_WAIT_V(8); PG8_WAIT_L(0); PG8_BAR; PG8_MMA(1, 0, At, B0); PG8_MMA(1, 1, At, B1); PG8_BAR; PG8_SCHED;
        PG8_LDB(B0, 1, 0); PG8_LDB(B1, 1, 1); PG8_SCHED; PG8_LDA(At, 1, 0); PG8_STAGE(PG8_SA(0, 1), a2 + hstep);
        PG8_WAIT_V(8); PG8_WAIT_L(0); PG8_BAR; PG8_MMA(0, 0, At, B0); PG8_MMA(0, 1, At, B1); PG8_BAR; PG8_SCHED;
        PG8_LDA(At, 1, 1); PG8_STAGEB(PG8_SB(1, 0), b3); PG8_STAGEB(PG8_SB(1, 1), b3 + hstep); PG8_STAGE(PG8_SA(1, 0), a3);
        PG8_WAIT_V(8); PG8_WAIT_L(0); PG8_BAR; PG8_MMA(1, 0, At, B0); PG8_MMA(1, 1, At, B1); PG8_BAR; PG8_SCHED;
        } else {
        PG8_LDB(B0, 0, 0); PG8_SCHED; PG8_LDA(At, 0, 0); PG8_STAGE(PG8_SA(1, 1), a1 + hstep);
        PG8_WAIT_L(8); PG8_BAR; PG8_WAIT_L(0); PG8_MMA(0, 0, At, B0); PG8_BAR; PG8_SCHED;
        PG8_LDB(B1, 0, 1); PG8_STAGEB(PG8_SB(0, 0), b2);
        PG8_BAR; PG8_WAIT_L(0); PG8_MMA(0, 1, At, B1); PG8_BAR;
        PG8_LDA(At, 0, 1); PG8_STAGE(PG8_SA(0, 0), a2);
        PG8_BAR; PG8_WAIT_L(0); PG8_MMA(1, 0, At, B0); PG8_BAR; PG8_SCHED;
        PG8_STAGEB(PG8_SB(0, 1), b2 + hstep);
        PG8_WAIT_V(6); PG8_BAR; PG8_MMA(1, 1, At, B1); PG8_BAR;
        PG8_LDB(B0, 1, 0); PG8_SCHED; PG8_LDA(At, 1, 0); PG8_STAGE(PG8_SA(0, 1), a2 + hstep);
        PG8_WAIT_L(8); PG8_BAR; PG8_WAIT_L(0); PG8_MMA(0, 0, At, B0); PG8_BAR; PG8_SCHED;
        PG8_LDB(B1, 1, 1); PG8_STAGEB(PG8_SB(1, 0), b3);
        PG8_BAR; PG8_WAIT_L(0); PG8_MMA(0, 1, At, B1); PG8_BAR;
        PG8_LDA(At, 1, 1); PG8_STAGE(PG8_SA(1, 0), a3);
        PG8_BAR; PG8_WAIT_L(0); PG8_MMA(1, 0, At, B0); PG8_BAR; PG8_SCHED;
        PG8_STAGEB(PG8_SB(1, 1), b3 + hstep);
        PG8_WAIT_V(6); PG8_BAR; PG8_MMA(1, 1, At, B1); PG8_BAR;
        }
      }
      if (G_ALIGN) { if (wr == 0) PG8_BAR; }
#pragma unroll
      for (int ai = 0; ai < 2; ++ai)
#pragma unroll
        for (int bj = 0; bj < 2; ++bj)
#pragma unroll
          for (int m = 0; m < 4; ++m)
            epi(cur.brow + ai * HALF + wr * 64 + m * 16 + fr, cur.bcol + bj * HALF + wc * 32 + fq * 8, acc[ai][bj][m][0], acc[ai][bj][m][1], cur.piece);
      if (!has_next) break;
#pragma unroll
      for (int a = 0; a < 2; ++a)
#pragma unroll
        for (int b = 0; b < 2; ++b)
#pragma unroll
          for (int m = 0; m < 4; ++m)
#pragma unroll
            for (int n = 0; n < 2; ++n) acc[a][b][m][n] = (f32x4){0.f, 0.f, 0.f, 0.f};
      cur = nxt; cA = nA; cB = nB; ++ui;
      if (G_ALIGN) { if (wr == 1) PG8_BAR; }
    }
    PG8_WAIT_V(0);
    if (!G_ALIGN) { if (wr == 0) PG8_BAR; }
    PG8_BAR;
  }
  __syncthreads();
#undef PG8_SA
#undef PG8_SB
#undef PG8_STAGE
#undef PG8_STAGEB
#undef PG8_STAGE_
#undef PG8_LDA
#undef PG8_LDB
#undef PG8_MMA
#undef PG8_WAIT_V
#undef PG8_WAIT_L
#undef PG8_BAR
#undef PG8_SCHED
#undef PG8_APTR
#undef PG8_BPTR
}

__device__ void mods_phase(unsigned char* lds, const Params& p) {
  float* sl = (float*)lds;
  float* red = sl + 9 * 1024;
  const int tid = opaque_tid();
  const float* c = p.in[1];
  const float* cc = p.in[3];
  float* mod = (float*)(p.ws + OFF_MOD);
  for (int tile = blockIdx.x; tile < 384; tile += gridDim.x) {
    const int l = tile / 192, cb = (tile % 192) * 32;
    for (int i = tid; i < 9 * 1024; i += 512) {
      float v = (i < 8192) ? c[i] : cc[i - 8192];
      sl[i] = siluf(v);
    }
    __syncthreads();
    const int cl = tid & 31, ks = tid >> 5;
    const float* aw = p.in[4] + (size_t)l * 1024 * 6144 + cb + cl;
    float acc[9];
#pragma unroll
    for (int r = 0; r < 9; ++r) acc[r] = 0.f;
    for (int k0 = ks * 64; k0 < ks * 64 + 64; k0 += 16) {
      float av[16];
#pragma unroll
      for (int u = 0; u < 16; ++u) av[u] = aw[(size_t)(k0 + u) * 6144];
#pragma unroll
      for (int u = 0; u < 16; ++u)
#pragma unroll
        for (int r = 0; r < 9; ++r) acc[r] += sl[r * 1024 + k0 + u] * av[u];
    }
#pragma unroll
    for (int r = 0; r < 9; ++r) red[(ks * 9 + r) * 32 + cl] = acc[r];
    __syncthreads();
    if (tid < 288) {
      const int r = tid >> 5, c2 = tid & 31;
      float s = 0.f;
      for (int q = 0; q < 16; ++q) s += red[(q * 9 + r) * 32 + c2];
      mod[((size_t)l * 9 + r) * 6144 + cb + c2] = s + p.in[5][(size_t)l * 6144 + cb + c2];
    }
    __syncthreads();
  }
}

__device__ __forceinline__ void convert_item(const float* src, int ldn, int K, bf16_t* dst, int kt, int nt, int srccol0, int tid) {
  const int nn = tid & 63, kc = tid >> 6;
  const float* sp = src + (size_t)(kt * 64 + kc * 8) * ldn + srccol0 + nn;
  float f[8];
#pragma unroll
  for (int i = 0; i < 8; ++i) f[i] = sp[(size_t)i * ldn];
  *(uint4*)(dst + (size_t)(nt * 64 + nn) * K + kt * 64 + kc * 8) = pack8(f);
}
__device__ void convert_win_wout(unsigned char* lds, const Params& p, int l, int first, int stride) {
  bf16_t* wint = (bf16_t*)(p.ws + OFF_WIN);
  bf16_t* woutt = (bf16_t*)(p.ws + OFF_WOUT);
  const float* win = p.in[8] + (size_t)l * 1024 * 3344;
  const float* wout = p.in[25] + (size_t)l * 1024 * 1024;
  const int tid = opaque_tid();
  for (int tile = first; tile < 832 + 256; tile += stride) {
    if (tile < 832) {
      const int nt = tile >> 4, kt = tile & 15;
      const int n0 = nt * 64;
      convert_item(win, 3344, 1024, wint, kt, nt, n0 < 2816 ? n0 : n0 + 16, tid);
    } else {
      const int t2 = tile - 832;
      const int nt = t2 >> 4, kt = t2 & 15;
      convert_item(wout, 1024, 1024, woutt, kt, nt, nt * 64, tid);
    }
  }
}
__device__ void convert_w1_w2(unsigned char* lds, const Params& p, int l, int first, int stride, int tile_hi = 2048) {
  bf16_t* w1t = (bf16_t*)(p.ws + OFF_W1);
  bf16_t* w2t = (bf16_t*)(p.ws + OFF_W2);
  const float* w1 = p.in[26] + (size_t)l * 1024 * 4096;
  const float* w2 = p.in[27] + (size_t)l * 4096 * 1024;
  const int tid = opaque_tid();
  for (int tile = first; tile < tile_hi; tile += stride) {
    if (tile < 1024) {
      const int nt = tile >> 4, kt = tile & 15;
      convert_item(w1, 4096, 1024, w1t, kt, nt, nt * 64, tid);
    } else {
      const int t2 = tile - 1024;
      const int nt = t2 >> 6, kt = t2 & 63;
      convert_item(w2, 1024, 4096, w2t, kt, nt, nt * 64, tid);
    }
  }
}

__device__ void rgw_phase(const Params& p) {
  bf16_t* rgw = (bf16_t*)(p.ws + OFF_RGW);
  const int tid = opaque_tid();
  for (int idx = blockIdx.x * 512 + tid; idx < 2 * 16 * 4096; idx += gridDim.x * 512) {
    const int i = idx & 63, j = (idx >> 6) & 63, mat = idx >> 12;
    rgw[idx] = f2bf(p.in[21][(size_t)mat * 4096 + i * 64 + j]);
  }
}

__device__ void filters_phase(unsigned char* lds, const Params& p) {
  float* feats = (float*)lds;
  float* h1 = feats + 8 * 33;
  float* h2 = h1 + 8 * 64;
  const int tid = opaque_tid();
  float* filt = (float*)(p.ws + OFF_FILT);
  for (int tile = blockIdx.x; tile < 576; tile += gridDim.x) {
    const int l = tile / 288, pt = tile % 288;
    const int posidx0 = pt * 8;
    const int L = (posidx0 < 2048) ? 2048 : 256;
    const int pos0 = (posidx0 < 2048) ? posidx0 : posidx0 - 2048;
    const float* w1 = p.in[10] + l * 33 * 64;
    const float* b1 = p.in[11] + l * 64;
    const float* w2 = p.in[12] + l * 64 * 64;
    const float* b2 = p.in[13] + l * 64;
    const float* w3 = p.in[14] + l * 64 * 512;
    const float* b3 = p.in[15] + l * 512;
    const float* fq = p.in[16] + l * 128;
    if (tid < 8 * 33) {
      const int pp = tid / 33, f = tid % 33;
      const float pos = (float)(pos0 + pp);
      float v;
      if (f == 0) v = pos / (float)(L - 1);
      else {
        const int bi = (f - 1) & 15;
        const float fr = 1e-4f + (float)bi * ((15.0f - 1e-4f) / 15.0f);
        const float kk = (float)(2.0 * 3.14159265358979323846 / (double)L);
        const float ang = (kk * fr) * pos;
        v = (f <= 16) ? cosf(ang) : -sinf(ang);
      }
      feats[pp * 33 + f] = v;
    }
    __syncthreads();
    {
      const int pp = tid >> 6, j = tid & 63;
      float s = b1[j];
      for (int f = 0; f < 33; ++f) s += feats[pp * 33 + f] * w1[f * 64 + j];
      h1[pp * 64 + j] = sinf(fq[j] * s);
    }
    __syncthreads();
    {
      const int pp = tid >> 6, j = tid & 63;
      float s = b2[j];
      for (int i = 0; i < 64; ++i) s += h1[pp * 64 + i] * w2[i * 64 + j];
      h2[pp * 64 + j] = sinf(fq[64 + j] * s);
    }
    __syncthreads();
    {
      const int col = tid;
      const int dir = col >> 8, c = col & 255;
      float acc[8];
#pragma unroll
      for (int pp = 0; pp < 8; ++pp) acc[pp] = b3[col];
      for (int i = 0; i < 64; ++i) {
        const float wv = w3[i * 512 + col];
#pragma unroll
        for (int pp = 0; pp < 8; ++pp) acc[pp] += h2[pp * 64 + i] * wv;
      }
      const float mind = -3.0701134573253944f, maxd = -15.350567286626973f;
      const float delta = fabsf(mind + (float)c * ((maxd - mind) / 255.0f));
      float* dst = filt + ((size_t)(l * 256 + c) * 2 + dir) * LTOT + posidx0;
#pragma unroll
      for (int pp = 0; pp < 8; ++pp) {
        const float t = (float)(pos0 + pp) / (float)(L - 1);
        dst[pp] = acc[pp] * expf(-t * delta);
      }
    }
    __syncthreads();
  }
}

template <int NR, bool GATES>
__device__ void norm_phase(unsigned char* lds, const Params& p, int l, const float* xlat, const float* xctx, const float* cadd, const float* gamma, int shift_i, int nrows) {
  const int tid = opaque_tid(), lane = tid & 63, w = tid >> 6;
  const float* mod = (const float*)(p.ws + OFF_MOD) + (size_t)l * 9 * 6144;
  bf16_t* act = (bf16_t*)(p.ws + OFF_ACT);
  float* G = (float*)(p.ws + OFF_G);
  const float* gb = p.in[19] + l * 16;
  float* wT = (float*)lds;
  if (GATES) {
    const float* wg = p.in[8] + (size_t)l * 1024 * 3344 + 2816;
#pragma unroll
    for (int kk = 0; kk < 2; ++kk) {
      const int k = tid + 512 * kk;
      const float4 a0 = *(const float4*)(wg + (size_t)k * 3344);
      const float4 a1 = *(const float4*)(wg + (size_t)k * 3344 + 4);
      const float4 a2 = *(const float4*)(wg + (size_t)k * 3344 + 8);
      const float4 a3 = *(const float4*)(wg + (size_t)k * 3344 + 12);
      wT[0 * 1024 + k] = a0.x; wT[1 * 1024 + k] = a0.y; wT[2 * 1024 + k] = a0.z; wT[3 * 1024 + k] = a0.w;
      wT[4 * 1024 + k] = a1.x; wT[5 * 1024 + k] = a1.y; wT[6 * 1024 + k] = a1.z; wT[7 * 1024 + k] = a1.w;
      wT[8 * 1024 + k] = a2.x; wT[9 * 1024 + k] = a2.y; wT[10 * 1024 + k] = a2.z; wT[11 * 1024 + k] = a2.w;
      wT[12 * 1024 + k] = a3.x; wT[13 * 1024 + k] = a3.y; wT[14 * 1024 + k] = a3.z; wT[15 * 1024 + k] = a3.w;
    }
    __syncthreads();
  }
  for (int r00 = (blockIdx.x * 8 + w) * NR; r00 < REP_NORM * nrows; r00 += gridDim.x * 8 * NR) {
    const int r0 = (REP_NORM > 1) ? r00 % nrows : r00;
    const float* mr[NR];
    const float* src[NR];
    float rstd[NR];
#pragma unroll
    for (int q = 0; q < NR; ++q) {
      const int r = r0 + q;
      if (r < NLAT) { src[q] = xlat + (size_t)r * 1024; mr[q] = mod + (size_t)(r >> 11) * 6144; }
      else { src[q] = xctx + (size_t)(r - NLAT) * 1024; mr[q] = mod + (size_t)8 * 6144; }
    }
    float ga[NR][16];
#pragma unroll
    for (int q = 0; q < NR; ++q)
#pragma unroll
      for (int g = 0; g < 16; ++g) ga[q][g] = 0.f;
    if (!GATES) {
      float4 v[NR][4];
#pragma unroll
      for (int q = 0; q < NR; ++q)
#pragma unroll
        for (int i = 0; i < 4; ++i) v[q][i] = *(const float4*)(src[q] + i * 256 + lane * 4);
#pragma unroll
      for (int q = 0; q < NR; ++q) {
        float ss = 0.f;
#pragma unroll
        for (int i = 0; i < 4; ++i) ss += v[q][i].x * v[q][i].x + v[q][i].y * v[q][i].y + v[q][i].z * v[q][i].z + v[q][i].w * v[q][i].w;
        ss = wsum(ss, lane);
        rstd[q] = rsqrtf(ss * (1.f / 1024.f) + EPSF);
      }
#pragma unroll
      for (int i = 0; i < 4; ++i) {
        const int k = i * 256 + lane * 4;
        const float4 g4 = *(const float4*)(gamma + k);
#pragma unroll
        for (int q = 0; q < NR; ++q) {
          const float4 sh = *(const float4*)(mr[q] + shift_i * 1024 + k);
          const float4 sc = *(const float4*)(mr[q] + (shift_i + 1) * 1024 + k);
          const float o0 = (v[q][i].x * rstd[q] * g4.x) * (1.f + sc.x) + sh.x;
          const float o1 = (v[q][i].y * rstd[q] * g4.y) * (1.f + sc.y) + sh.y;
          const float o2 = (v[q][i].z * rstd[q] * g4.z) * (1.f + sc.z) + sh.z;
          const float o3 = (v[q][i].w * rstd[q] * g4.w) * (1.f + sc.w) + sh.w;
          uint2 pk; pk.x = pack2(o0, o1); pk.y = pack2(o2, o3);
          *(uint2*)(act + (size_t)(r0 + q) * 1024 + k) = pk;
        }
      }
    } else {
#pragma unroll
      for (int q = 0; q < NR; ++q) {
        float ss = 0.f;
#pragma unroll
        for (int i = 0; i < 4; ++i) {
          float4 t4 = *(const float4*)(src[q] + i * 256 + lane * 4);
          if (cadd != nullptr && r0 + q >= NLAT) {
            const float4 a1 = *(const float4*)(cadd + (size_t)(r0 + q - NLAT) * 1024 + i * 256 + lane * 4);
            const float4 a2 = *(const float4*)(cadd + (size_t)2048 * 1024 + (size_t)(r0 + q - NLAT) * 1024 + i * 256 + lane * 4);
            t4.x += a1.x + a2.x; t4.y += a1.y + a2.y; t4.z += a1.z + a2.z; t4.w += a1.w + a2.w;
          }
          ss += t4.x * t4.x + t4.y * t4.y + t4.z * t4.z + t4.w * t4.w;
        }
        ss = wsum(ss, lane);
        rstd[q] = rsqrtf(ss * (1.f / 1024.f) + EPSF);
      }
#pragma unroll 1
      for (int i = 0; i < 4; ++i) {
        const int k = i * 256 + lane * 4;
        const float4 g4 = *(const float4*)(gamma + k);
        float o[NR][4];
#pragma unroll
        for (int q = 0; q < NR; ++q) {
          float4 vv = *(const float4*)(src[q] + k);
          if (cadd != nullptr && r0 + q >= NLAT) {
            const float4 a1 = *(const float4*)(cadd + (size_t)(r0 + q - NLAT) * 1024 + k);
            const float4 a2 = *(const float4*)(cadd + (size_t)2048 * 1024 + (size_t)(r0 + q - NLAT) * 1024 + k);
            vv.x += a1.x + a2.x; vv.y += a1.y + a2.y; vv.z += a1.z + a2.z; vv.w += a1.w + a2.w;
          }
          const float4 sh = *(const float4*)(mr[q] + shift_i * 1024 + k);
          const float4 sc = *(const float4*)(mr[q] + (shift_i + 1) * 1024 + k);
          o[q][0] = (vv.x * rstd[q] * g4.x) * (1.f + sc.x) + sh.x;
          o[q][1] = (vv.y * rstd[q] * g4.y) * (1.f + sc.y) + sh.y;
          o[q][2] = (vv.z * rstd[q] * g4.z) * (1.f + sc.z) + sh.z;
          o[q][3] = (vv.w * rstd[q] * g4.w) * (1.f + sc.w) + sh.w;
          uint2 pk; pk.x = pack2(o[q][0], o[q][1]); pk.y = pack2(o[q][2], o[q][3]);
          *(uint2*)(act + (size_t)(r0 + q) * 1024 + k) = pk;
        }
#pragma unroll
        for (int g = 0; g < 16; ++g) {
          const float4 w4 = *(const float4*)(wT + g * 1024 + k);
#pragma unroll
          for (int q = 0; q < NR; ++q) ga[q][g] += o[q][0] * w4.x + o[q][1] * w4.y + o[q][2] * w4.z + o[q][3] * w4.w;
        }
      }
    }
    if (GATES) {
#pragma unroll
      for (int q = 0; q < NR; ++q) {
        float r8[8], r4[4], r2[2];
        const bool b5 = (lane & 32) != 0, b4 = (lane & 16) != 0, b3 = (lane & 8) != 0, b2 = (lane & 4) != 0;
#pragma unroll
        for (int j = 0; j < 8; ++j) {
          const float mine = b5 ? ga[q][j + 8] : ga[q][j];
          const float send = b5 ? ga[q][j] : ga[q][j + 8];
          r8[j] = mine + shfl_idx(send, lane ^ 32);
        }
#pragma unroll
        for (int j = 0; j < 4; ++j) {
          const float mine = b4 ? r8[j + 4] : r8[j];
          const float send = b4 ? r8[j] : r8[j + 4];
          r4[j] = mine + shfl_idx(send, lane ^ 16);
        }
#pragma unroll
        for (int j = 0; j < 2; ++j) {
          const float mine = b3 ? r4[j + 2] : r4[j];
          const float send = b3 ? r4[j] : r4[j + 2];
          r2[j] = mine + shfl_idx(send, lane ^ 8);
        }
        float tot;
        {
          const float mine = b2 ? r2[1] : r2[0];
          const float send = b2 ? r2[0] : r2[1];
          tot = mine + shfl_idx(send, lane ^ 4);
        }
        tot += shfl_idx(tot, lane ^ 2);
        tot += shfl_idx(tot, lane ^ 1);
        const int gidx = ((lane >> 2) & 1) | (((lane >> 3) & 1) << 1) | (((lane >> 4) & 1) << 2) | (((lane >> 5) & 1) << 3);
        if ((lane & 3) == 0) G[(size_t)(r0 + q) * 16 + gidx] = tot + gb[gidx];
      }
    }
  }
  if (GATES) __syncthreads();
}

__device__ void final_norm_phase(const Params& p) {
  const int tid = opaque_tid(), lane = tid & 63, w = tid >> 6;
  const float* gamma = p.in[28];
  for (int r0 = (blockIdx.x * 8 + w) * 4; r0 < NLAT; r0 += gridDim.x * 8 * 4) {
    float4 v[4][4];
    float rstd[4];
#pragma unroll
    for (int q = 0; q < 4; ++q) {
      const float* src = p.out + (size_t)(r0 + q) * 1024;
      float ss = 0.f;
#pragma unroll
      for (int i = 0; i < 4; ++i) {
        v[q][i] = *(const float4*)(src + i * 256 + lane * 4);
        ss += v[q][i].x * v[q][i].x + v[q][i].y * v[q][i].y + v[q][i].z * v[q][i].z + v[q][i].w * v[q][i].w;
      }
      ss = wsum(ss, lane);
      rstd[q] = rsqrtf(ss * (1.f / 1024.f) + EPSF);
    }
#pragma unroll
    for (int i = 0; i < 4; ++i) {
      const int k = i * 256 + lane * 4;
      const float4 g4 = *(const float4*)(gamma + k);
#pragma unroll
      for (int q = 0; q < 4; ++q) {
        float4 o;
        o.x = v[q][i].x * rstd[q] * g4.x; o.y = v[q][i].y * rstd[q] * g4.y; o.z = v[q][i].z * rstd[q] * g4.z; o.w = v[q][i].w * rstd[q] * g4.w;
        *(float4*)(p.out + (size_t)(r0 + q) * 1024 + k) = o;
      }
    }
  }
}

__device__ __forceinline__ int ml_row_pos(int b, bool isctx, int pos) {
  return isctx ? (NLAT + b * 256 + pos) : (b * 2048 + (pos & 31) * 64 + (pos >> 5));
}
__device__ __forceinline__ int sidx(int dir, int b, int h, int n) { return ((dir * 8 + b) * 4 + h) * 18 + n; }

__device__ __forceinline__ void ml_conv8_load(const bf16_t* z, int zcol, int b, bool isctx, int L, int pos, uint4* u) {
#pragma unroll
  for (int j = 0; j < 4; ++j) {
    const int pp = pos + j - 1;
    const int pc = pp < 0 ? 0 : (pp >= L ? L - 1 : pp);
    u[j] = *(const uint4*)(z + (size_t)ml_row_pos(b, isctx, pc) * ZS + zcol);
  }
}
__device__ __forceinline__ void ml_conv8_comp(const uint4* u, const float* wc, int ccol, int L, int pos, float* o) {
#pragma unroll
  for (int e = 0; e < 8; ++e) o[e] = 0.f;
#pragma unroll
  for (int j = 0; j < 4; ++j) {
    const int pp = pos + j - 1;
    const float mk = (pp >= 0 && pp < L) ? 1.f : 0.f;
    float f[8];
    unpack8(u[j], f);
    const float4 w0 = *(const float4*)(wc + j * 1024 + ccol);
    const float4 w1 = *(const float4*)(wc + j * 1024 + ccol + 4);
    o[0] += f[0] * (w0.x * mk); o[1] += f[1] * (w0.y * mk); o[2] += f[2] * (w0.z * mk); o[3] += f[3] * (w0.w * mk);
    o[4] += f[4] * (w1.x * mk); o[5] += f[5] * (w1.y * mk); o[6] += f[6] * (w1.z * mk); o[7] += f[7] * (w1.w * mk);
  }
#pragma unroll
  for (int e = 0; e < 8; ++e) o[e] = siluf(o[e]);
}
__device__ __forceinline__ void ml_conv8(const bf16_t* z, const float* wc, int zcol, int ccol, int b, bool isctx, int L, int pos, float* o) {
  uint4 u[4];
  ml_conv8_load(z, zcol, b, isctx, L, pos, u);
  ml_conv8_comp(u, wc, ccol, L, pos, o);
}

__device__ __forceinline__ void ml_prep_load(const float* G, int b, int n, int h, int tid, float* g4) {
  const bool isctx = n < 2;
  const int p0 = isctx ? n * 128 : (n - 2) * 128;
  const float* g = G + (size_t)ml_row_pos(b, isctx, p0 + (tid & 127)) * 16;
  g4[0] = g[0 + h]; g4[1] = g[4 + h]; g4[2] = g[8 + h]; g4[3] = g[12 + h];
}
__device__ __forceinline__ void ml_prep(float* vec, const float* g4, float* scal, int b, int n, int h, bool outmode) {
  const int tid = opaque_tid();
  if (tid < 128) {
    vec[0 * 128 + tid] = g4[0];
    vec[1 * 128 + tid] = logsig(g4[1]);
    vec[2 * 128 + tid] = g4[2];
    vec[3 * 128 + tid] = logsig(g4[3]);
  }
  __syncthreads();
  if (tid < 128) {
    const int dir = tid >> 6, lane = tid & 63;
    const float* LI = vec + (dir * 2) * 128;
    const float* LF = vec + (dir * 2 + 1) * 128;
    const int i0 = dir ? 127 - 2 * lane : 2 * lane;
    const int i1 = dir ? i0 - 1 : i0 + 1;
    const float x0 = LF[i0], x1 = LF[i1];
    const float s2 = x0 + x1;
    float inc = s2;
#pragma unroll
    for (int o = 1; o < 64; o <<= 1) { const float t = shfl_idx(inc, lane - o); if (lane >= o) inc += t; }
    const float b0 = inc - s2 + x0, b1 = inc;
    const float btot = shfl_idx(inc, 63);
    const float li0 = LI[i0], li1 = LI[i1];
    const int sid = sidx(dir, b, h, n);
    if (!outmode) {
      const float g0 = btot - b0 + li0, g1 = btot - b1 + li1;
      float mx = fmaxf(g0, g1);
#pragma unroll
      for (int o = 32; o > 0; o >>= 1) mx = fmaxf(mx, shfl_idx(mx, lane ^ o));
      vec[(6 + dir) * 128 + i0] = fexp(g0 - mx);
      vec[(6 + dir) * 128 + i1] = fexp(g1 - mx);
      if (lane == 0) { scal[sid] = btot; scal[1152 + sid] = mx; }
    } else {
      const float m0 = scal[2304 + sid];
      const float c0 = li0 - b0, c1 = li1 - b1;
      float rmx = fmaxf(c0, c1);
#pragma unroll
      for (int o = 1; o < 64; o <<= 1) { const float t = shfl_idx(rmx, lane - o); if (lane >= o) rmx = fmaxf(rmx, t); }
      float prev = shfl_idx(rmx, lane - 1);
      if (lane == 0) prev = -INFINITY;
      const float r0 = fmaxf(prev, c0), r1 = rmx;
      float* base = vec + (6 + 4 * dir) * 128;
      {
        const float inter = b0 + m0, mt = fmaxf(inter, b0 + r0);
        base[i0] = b0 - mt; base[128 + i0] = c0; base[256 + i0] = fexp(inter - mt); base[384 + i0] = fexp(-mt);
      }
      {
        const float inter = b1 + m0, mt = fmaxf(inter, b1 + r1);
        base[i1] = b1 - mt; base[128 + i1] = c1; base[256 + i1] = fexp(inter - mt); base[384 + i1] = fexp(-mt);
      }
    }
  }
  __syncthreads();
}

__device__ void ml_local_tile(unsigned char* lds, const Params& p, int l, int b, int h, int n) {
  bf16_t* KT = (bf16_t*)lds;
  bf16_t* VF = KT + 128 * 136;
  bf16_t* VB = VF + 128 * 136;
  float* vec = (float*)(VB + 128 * 136);
  const int tid = opaque_tid(), lane = tid & 63, w = tid >> 6, lr = lane & 15, lg = lane >> 4;
  const bf16_t* z = (const bf16_t*)(p.ws + OFF_A);
  const float* G = (const float*)(p.ws + OFF_G);
  bf16_t* Cst = (bf16_t*)(p.ws + OFF_ST);
  float* nst = (float*)(p.ws + OFF_NST);
  float* scal = (float*)(p.ws + OFF_SCAL);
  const bool isctx = n < 2;
  const int L = isctx ? 256 : 2048;
  const int p0 = isctx ? n * 128 : (n - 2) * 128;
  float g4[4];
  ml_prep_load(G, b, n, h, tid, g4);
  uint4 ku[4][4], vu[4];
  {
    const int s = tid & 127, ec0 = tid >> 7;
    const int row = ml_row_pos(b, isctx, p0 + s);
#pragma unroll
    for (int i = 0; i < 4; ++i) {
      const int ec = ec0 + 4 * i;
      ml_conv8_load(z, 768 + 512 + h * 128 + ec * 8, b, isctx, L, p0 + s, ku[i]);
      vu[i] = *(const uint4*)(z + (size_t)row * ZS + 768 + 1024 + h * 128 + ec * 8);
    }
  }
  ml_prep(vec, g4, scal, b, n, h, false);
  {
    const int s = tid & 127, ec0 = tid >> 7;
    const float wf = vec[6 * 128 + s], wb = vec[7 * 128 + s];
    const float* wc = p.in[18] + (size_t)l * 4 * 1024;
#pragma unroll
    for (int i = 0; i < 4; ++i) {
      const int ec = ec0 + 4 * i;
      float k8[8];
      ml_conv8_comp(ku[i], wc, 512 + h * 128 + ec * 8, L, p0 + s, k8);
      float v8[8];
      unpack8(vu[i], v8);
#pragma unroll
      for (int e = 0; e < 8; ++e) {
        KT[(ec * 8 + e) * 136 + s] = f2bf(k8[e] * 0.08838834764831845f);
        VF[(ec * 8 + e) * 136 + s] = f2bf(v8[e] * wf);
        VB[(ec * 8 + e) * 136 + s] = f2bf(v8[e] * wb);
      }
    }
  }
  __syncthreads();
  {
    f32x4 accf[8], accb[8];
#pragma unroll
    for (int i = 0; i < 8; ++i) { accf[i] = (f32x4){0.f, 0.f, 0.f, 0.f}; accb[i] = (f32x4){0.f, 0.f, 0.f, 0.f}; }
#pragma unroll
    for (int ks = 0; ks < 4; ++ks) {
      const bf16x8 bfv = ldfrag(VF + (16 * w + lr) * 136 + ks * 32 + lg * 8);
      const bf16x8 bbv = ldfrag(VB + (16 * w + lr) * 136 + ks * 32 + lg * 8);
#pragma unroll
      for (int ef = 0; ef < 8; ++ef) {
        const bf16x8 a = ldfrag(KT + (ef * 16 + lr) * 136 + ks * 32 + lg * 8);
        accf[ef] = mfma16(a, bfv, accf[ef]);
        accb[ef] = mfma16(a, bbv, accb[ef]);
      }
    }
    bf16_t* cf = Cst + (size_t)sidx(0, b, h, n) * 16384 + (16 * w + lr) * 128;
    bf16_t* cb = Cst + (size_t)sidx(1, b, h, n) * 16384 + (16 * w + lr) * 128;
#pragma unroll
    for (int ef = 0; ef < 8; ++ef) {
      uint2 u; u.x = pack2(accf[ef][0], accf[ef][1]); u.y = pack2(accf[ef][2], accf[ef][3]);
      *(uint2*)(cf + ef * 16 + lg * 4) = u;
      uint2 u2; u2.x = pack2(accb[ef][0], accb[ef][1]); u2.y = pack2(accb[ef][2], accb[ef][3]);
      *(uint2*)(cb + ef * 16 + lg * 4) = u2;
    }
  }
  if (tid < 256) {
    const int e = tid & 127, dir = tid >> 7;
    const float* wv = vec + (6 + dir) * 128;
    float s = 0.f;
    for (int q = 0; q < 128; ++q) s += wv[q] * bf2f(KT[e * 136 + q]);
    nst[(size_t)sidx(dir, b, h, n) * 128 + e] = s;
  }
  __syncthreads();
}

__device__ void ml_scan_phase(const Params& p) {
  const int tid = opaque_tid();
  bf16_t* Cst = (bf16_t*)(p.ws + OFF_ST);
  float* nst = (float*)(p.ws + OFF_NST);
  float* scal = (float*)(p.ws + OFF_SCAL);
  for (int tile = blockIdx.x; tile < 512; tile += gridDim.x) {
    const int slice = tile & 7, seq = tile >> 3;
    const int h = seq & 3, b = (seq >> 2) & 7, dir = seq >> 5;
    const bool don = (slice == 0 && tid < 128);
    uint2 u[18];
    float nl[18], bl[18], ml[18];
#pragma unroll
    for (int i = 0; i < 18; ++i) {
      const int n = (dir == 0) ? i : (i < 2 ? 1 - i : 19 - i);
      const int sid = sidx(dir, b, h, n);
      u[i] = *(const uint2*)(Cst + (size_t)sid * 16384 + slice * 2048 + tid * 4);
      nl[i] = don ? nst[(size_t)sid * 128 + tid] : 0.f;
      bl[i] = scal[sid];
      ml[i] = scal[1152 + sid];
    }
    float m = 0.f;
    float zz = 0.f;
    asm volatile("" : "+v"(zz));
    float cr[4] = {zz, zz, zz, zz};
    float nr = zz;
#pragma unroll
    for (int i = 0; i < 18; ++i) {
      const int n = (dir == 0) ? i : (i < 2 ? 1 - i : 19 - i);
      const int sid = sidx(dir, b, h, n);
      const float mnew = fmaxf(bl[i] + m, ml[i]);
      const float a = fexp(bl[i] + m - mnew), sc = fexp(ml[i] - mnew);
      uint2 o; o.x = pack2(cr[0], cr[1]); o.y = pack2(cr[2], cr[3]);
      *(uint2*)(Cst + (size_t)sid * 16384 + slice * 2048 + tid * 4) = o;
      cr[0] = a * cr[0] + sc * lo16(u[i].x); cr[1] = a * cr[1] + sc * hi16(u[i].x);
      cr[2] = a * cr[2] + sc * lo16(u[i].y); cr[3] = a * cr[3] + sc * hi16(u[i].y);
      if (don) {
        nst[(size_t)sid * 128 + tid] = nr;
        nr = a * nr + sc * nl[i];
      }
      if (slice == 0 && tid == 0) scal[2304 + sid] = m;
      m = mnew;
    }
  }
}

__device__ void ml_out_tile(unsigned char* lds, const Params& p, int l, int b, int h, int n) {
  bf16_t* C0s = (bf16_t*)lds;
  bf16_t* Ks = C0s + 128 * 136;
  bf16_t* VT = Ks + 128 * 136;
  bf16_t* Ps = VT + 128 * 136;
  float* vec = (float*)(Ps + 128 * 136);
  const int tid = opaque_tid(), lane = tid & 63, w = tid >> 6, lr = lane & 15, lg = lane >> 4;
  const bf16_t* z = (const bf16_t*)(p.ws + OFF_A);
  const float* G = (const float*)(p.ws + OFF_G);
  const bf16_t* Cst = (const bf16_t*)(p.ws + OFF_ST);
  const float* nst = (const float*)(p.ws + OFF_NST);
  const float* scal = (const float*)(p.ws + OFF_SCAL);
  bf16_t* y = (bf16_t*)(p.ws + OFF_ACT);
  const bool isctx = n < 2;
  const int L = isctx ? 256 : 2048;
  const int p0 = isctx ? n * 128 : (n - 2) * 128;
  const int t = 16 * w + lr;
  float g4[4];
  ml_prep_load(G, b, n, h, tid, g4);
  if (tid >= 128 && tid < 384) {
    const int q = tid - 128, dir = q >> 7, e = q & 127;
    vec[(14 + dir) * 128 + e] = nst[(size_t)sidx(dir, b, h, n) * 128 + e];
  }
  const int orow = ml_row_pos(b, isctx, p0 + t);
  uint2 ou[8];
#pragma unroll
  for (int df = 0; df < 8; ++df) ou[df] = make_uint2(0u, 0u);
  const float* wc = p.in[18] + (size_t)l * 4 * 1024;
  {
    const int s = tid & 127, ec0 = tid >> 7;
    const int row = ml_row_pos(b, isctx, p0 + s);
#pragma unroll 2
    for (int i = 0; i < 4; ++i) {
      const int ec = ec0 + 4 * i;
      float k8[8], v8[8];
      ml_conv8(z, wc, 768 + 512 + h * 128 + ec * 8, 512 + h * 128 + ec * 8, b, isctx, L, p0 + s, k8);
#pragma unroll
      for (int e = 0; e < 8; ++e) k8[e] *= 0.08838834764831845f;
      *(uint4*)(Ks + s * 136 + ec * 8) = pack8(k8);
      const uint4 vu = *(const uint4*)(z + (size_t)row * ZS + 768 + 1024 + h * 128 + ec * 8);
      unpack8(vu, v8);
#pragma unroll
      for (int e = 0; e < 8; ++e) VT[(ec * 8 + e) * 136 + s] = f2bf(v8[e]);
    }
  }
  uint4 c0f[4];
  {
    const bf16_t* Cf = Cst + (size_t)sidx(0, b, h, n) * 16384;
#pragma unroll
    for (int i = 0; i < 4; ++i) {
      const int id = tid + 512 * i;
      c0f[i] = *(const uint4*)(Cf + (id >> 4) * 128 + (id & 15) * 8);
    }
  }
  bf16x8 qf[4];
#pragma unroll
  for (int ks = 0; ks < 4; ++ks) {
    const int ec = ks * 4 + lg;
    float q8[8];
    ml_conv8(z, wc, 768 + h * 128 + ec * 8, h * 128 + ec * 8, b, isctx, L, p0 + t, q8);
    const uint4 pk = pack8(q8);
    qf[ks] = __builtin_bit_cast(bf16x8, pk);
  }
#pragma unroll
  for (int i = 0; i < 4; ++i) {
    const int id = tid + 512 * i;
    *(uint4*)(C0s + (id >> 4) * 136 + (id & 15) * 8) = c0f[i];
  }
  ml_prep(vec, g4, const_cast<float*>(scal), b, n, h, true);
  {
    float qnf = 0.f, qnb = 0.f;
#pragma unroll
    for (int ks = 0; ks < 4; ++ks) {
      float qv[8];
      unpack8(__builtin_bit_cast(uint4, qf[ks]), qv);
#pragma unroll
      for (int e = 0; e < 8; ++e) {
        qnf += qv[e] * vec[14 * 128 + (ks * 4 + lg) * 8 + e];
        qnb += qv[e] * vec[15 * 128 + (ks * 4 + lg) * 8 + e];
      }
    }
    qnf += shfl_idx(qnf, lane ^ 16); qnf += shfl_idx(qnf, lane ^ 32);
    qnb += shfl_idx(qnb, lane ^ 16); qnb += shfl_idx(qnb, lane ^ 32);
    if (lg == 0) { vec[17 * 128 + t] = qnf; vec[18 * 128 + t] = qnb; }
  }
  f32x4 hsum[8];
#pragma unroll
  for (int i = 0; i < 8; ++i) hsum[i] = (f32x4){0.f, 0.f, 0.f, 0.f};
#pragma unroll 1
  for (int dir = 0; dir < 2; ++dir) {
    uint4 cn[4];
    if (dir == 0) {
      const bf16_t* Cb = Cst + (size_t)sidx(1, b, h, n) * 16384;
#pragma unroll
      for (int i = 0; i < 4; ++i) {
        const int id = tid + 512 * i;
        cn[i] = *(const uint4*)(Cb + (id >> 4) * 128 + (id & 15) * 8);
      }
    } else {
#pragma unroll
      for (int i = 0; i < 4; ++i) cn[i] = make_uint4(0u, 0u, 0u, 0u);
#pragma unroll
      for (int df = 0; df < 8; ++df) ou[df] = *(const uint2*)(z + (size_t)orow * ZS + 768 + 1536 + h * 128 + df * 16 + lg * 4);
    }
    const float* ROWV = vec + (6 + 4 * dir) * 128;
    const float* COLV = vec + (7 + 4 * dir) * 128;
    const float* WI = vec + (8 + 4 * dir) * 128;
    const float* EM = vec + (9 + 4 * dir) * 128;
    const float* QN = vec + (17 + dir) * 128;
    float* DINV = vec + 16 * 128;
    {
      const float rv = ROWV[t];
#pragma unroll
      for (int sf = 0; sf < 8; ++sf) {
        f32x4 acc = (f32x4){0.f, 0.f, 0.f, 0.f};
#pragma unroll
        for (int ks = 0; ks < 4; ++ks) {
          const bf16x8 kf = ldfrag(Ks + (sf * 16 + lr) * 136 + ks * 32 + lg * 8);
          acc = mfma16(kf, qf[ks], acc);
        }
        float pv[4];
#pragma unroll
        for (int j = 0; j < 4; ++j) {
          const int s = sf * 16 + lg * 4 + j;
          const bool ok = (dir == 0) ? (s <= t) : (s >= t);
          pv[j] = ok ? acc[j] * fexp(rv + COLV[s]) : 0.f;
        }
        uint2 u; u.x = pack2(pv[0], pv[1]); u.y = pack2(pv[2], pv[3]);
        *(uint2*)(Ps + t * 136 + sf * 16 + lg * 4) = u;
      }
    }
    __syncthreads();
    if (tid < 128) {
      float rs = 0.f;
#pragma unroll
      for (int c8 = 0; c8 < 16; ++c8) {
        float f[8];
        unpack8(*(const uint4*)(Ps + tid * 136 + c8 * 8), f);
#pragma unroll
        for (int e = 0; e < 8; ++e) rs += f[e];
      }
      const float den = rs + WI[tid] * QN[tid];
      DINV[tid] = frcp(fmaxf(fabsf(den), EM[tid]));
    }
    __syncthreads();
    {
      bf16x8 pf[4];
#pragma unroll
      for (int ks = 0; ks < 4; ++ks) pf[ks] = ldfrag(Ps + t * 136 + ks * 32 + lg * 8);
      const float wi = WI[t];
      const float di = DINV[t];
#pragma unroll
      for (int df = 0; df < 8; ++df) {
        f32x4 a1 = (f32x4){0.f, 0.f, 0.f, 0.f}, a2 = (f32x4){0.f, 0.f, 0.f, 0.f};
#pragma unroll
        for (int ks = 0; ks < 4; ++ks) {
          const bf16x8 vf = ldfrag(VT + (df * 16 + lr) * 136 + ks * 32 + lg * 8);
          a1 = mfma16(vf, pf[ks], a1);
          const bf16x8 cf = ldfrag(C0s + (df * 16 + lr) * 136 + ks * 32 + lg * 8);
          a2 = mfma16(cf, qf[ks], a2);
        }
#pragma unroll
        for (int j = 0; j < 4; ++j) hsum[df][j] += (a1[j] + wi * a2[j]) * di;
      }
    }
    __syncthreads();
    if (dir == 0) {
#pragma unroll
      for (int i = 0; i < 4; ++i) {
        const int id = tid + 512 * i;
        *(uint4*)(C0s + (id >> 4) * 136 + (id & 15) * 8) = cn[i];
      }
    }
  }
  {
    float ss = 0.f;
#pragma unroll
    for (int df = 0; df < 8; ++df)
#pragma unroll
      for (int j = 0; j < 4; ++j) ss += hsum[df][j] * hsum[df][j];
    ss += shfl_idx(ss, lane ^ 16);
    ss += shfl_idx(ss, lane ^ 32);
    const float rn = rsqrtf(ss * (1.f / 128.f) + EPSF);
    const float* gm = p.in[24] + (size_t)l * 1024 + 256 + h * 128;
#pragma unroll
    for (int df = 0; df < 8; ++df) {
      const int d = df * 16 + lg * 4;
      const float4 gg = *(const float4*)(gm + d);
      float o0 = hsum[df][0] * rn * gg.x * sigm(lo16(ou[df].x));
      float o1 = hsum[df][1] * rn * gg.y * sigm(hi16(ou[df].x));
      float o2 = hsum[df][2] * rn * gg.z * sigm(lo16(ou[df].y));
      float o3 = hsum[df][3] * rn * gg.w * sigm(hi16(ou[df].y));
      uint2 u; u.x = pack2(o0, o1); u.y = pack2(o2, o3);
      *(uint2*)(y + (size_t)orow * 1024 + 256 + h * 128 + d) = u;
    }
  }
  __syncthreads();
}

__device__ void rg_tile(unsigned char* lds, const Params& p, int l, int b, int ck, int hh, bool outmode) {
  float* XR = (float*)lds;
  bf16_t* XB = (bf16_t*)(XR + 64 * 65);
  bf16_t* WT = XB + 64 * 72;
  float* AA = (float*)(WT + 256 * 72);
  float* BQ = AA + 2 * 64 * 64;
  const int tid = opaque_tid(), lane = tid & 63, w = tid >> 6, lr = lane & 15, lg = lane >> 4;
  const bf16_t* z = (const bf16_t*)(p.ws + OFF_A);
  bf16_t* y = (bf16_t*)(p.ws + OFF_ACT);
  float* agg = (float*)(p.ws + OFF_RGAGG);
  const float* car = (const float*)(p.ws + OFF_RGCAR);
  const bool isctx = ck < 4;
  const int L = isctx ? 256 : 2048;
  const int t0 = isctx ? ck * 64 : (ck - 4) * 64;
  const int rowbase = isctx ? (NLAT + b * 256) : (b * 2048);
  float car_pre = 0.f, gp_pre[8];
  {
    const int d_ = (tid >> 6) & 1, j_ = tid & 63;
    if (outmode) {
      car_pre = car[((size_t)(b * 36 + ck) * 2 + d_) * 256 + hh * 64 + j_];
#pragma unroll
      for (int q = 0; q < 8; ++q) gp_pre[q] = bf2f(z[(size_t)(rowbase + t0 + w * 8 + q) * ZS + 2816 + 256 + hh * 64 + lane]);
    } else {
#pragma unroll
      for (int q = 0; q < 8; ++q) gp_pre[q] = 0.f;
    }
  }
  const int chm_ = hh * 64 + (w & 3) * 16 + lr, dm_ = w >> 2;
  const float br = p.in[22][(size_t)l * 1024 + (dm_ * 2 + 0) * 256 + chm_];
  const float bi = p.in[22][(size_t)l * 1024 + (dm_ * 2 + 1) * 256 + chm_];
  const float lam_ = p.in[23][(size_t)l * 512 + dm_ * 256 + chm_];
  {
    const int i = tid & 63, tq = tid >> 6;
    const int ch = hh * 64 + i;
    const float* wc = p.in[20] + (size_t)l * 4 * 256 + ch;
    const float w0 = wc[0], w1 = wc[256], w2 = wc[512], w3 = wc[768];
#pragma unroll
    for (int ii = 0; ii < 8; ++ii) {
      const int tt = tq * 8 + ii;
      const int tp = t0 + tt;
      const int tm1 = tp - 1 >= 0 ? tp - 1 : 0, tp1 = tp + 1 < L ? tp + 1 : L - 1, tp2 = tp + 2 < L ? tp + 2 : L - 1;
      const float z0 = bf2f(z[(size_t)(rowbase + tm1) * ZS + 2816 + ch]);
      const float z1 = bf2f(z[(size_t)(rowbase + tp) * ZS + 2816 + ch]);
      const float z2 = bf2f(z[(size_t)(rowbase + tp1) * ZS + 2816 + ch]);
      const float z3 = bf2f(z[(size_t)(rowbase + tp2) * ZS + 2816 + ch]);
      float xr = w1 * z1;
      xr += (tp - 1 >= 0 ? w0 : 0.f) * z0;
      xr += (tp + 1 < L ? w2 : 0.f) * z2;
      xr += (tp + 2 < L ? w3 : 0.f) * z3;
      XR[tt * 65 + i] = xr;
      XB[tt * 72 + i] = f2bf(xr);
    }
    const bf16_t* rgw = (const bf16_t*)(p.ws + OFF_RGW);
#pragma unroll
    for (int q = 0; q < 4; ++q) {
      const int id = tid + 512 * q;
      const int row = id >> 3, kc = id & 7;
      *(uint4*)(WT + row * 72 + kc * 8) = *(const uint4*)(rgw + ((size_t)((l * 4 + (row >> 6)) * 4 + hh)) * 4096 + (row & 63) * 64 + kc * 8);
    }
  }
  __syncthreads();
  {
    const int d = w >> 2, jf = w & 3;
    f32x4 ar[4], ai[4];
#pragma unroll
    for (int i = 0; i < 4; ++i) { ar[i] = (f32x4){0.f, 0.f, 0.f, 0.f}; ai[i] = (f32x4){0.f, 0.f, 0.f, 0.f}; }
#pragma unroll
    for (int ks = 0; ks < 2; ++ks) {
      const bf16x8 wr = ldfrag(WT + ((d * 2 + 0) * 64 + jf * 16 + lr) * 72 + ks * 32 + lg * 8);
      const bf16x8 wi = ldfrag(WT + ((d * 2 + 1) * 64 + jf * 16 + lr) * 72 + ks * 32 + lg * 8);
#pragma unroll
      for (int tf = 0; tf < 4; ++tf) {
        const bf16x8 xf = ldfrag(XB + (tf * 16 + lr) * 72 + ks * 32 + lg * 8);
        ar[tf] = mfma16(xf, wr, ar[tf]);
        ai[tf] = mfma16(xf, wi, ai[tf]);
      }
    }
    const int j = jf * 16 + lr;
    const int ch = hh * 64 + j;
    const float sp = softplusf(-lam_);
#pragma unroll
    for (int tf = 0; tf < 4; ++tf)
#pragma unroll
      for (int jj = 0; jj < 4; ++jj) {
        const int tt = tf * 16 + lg * 4 + jj;
        const float r = sigm(ar[tf][jj] + br);
        const float ig = sigm(ai[tf][jj] + bi);
        const float la = -8.0f * r * sp;
        const float a = fexp(la);
        const float bq = __builtin_amdgcn_sqrtf(fmaxf(1.f - a * a, 0.f)) * ig * XR[tt * 65 + j];
        AA[(d * 64 + tt) * 64 + j] = a;
        BQ[(d * 64 + tt) * 64 + j] = bq;
      }
  }
  __syncthreads();
  {
    float* SEG = XR;
    const int seg = tid >> 7, d = (tid >> 6) & 1, j = tid & 63;
    const int ch = hh * 64 + j;
    const size_t ci = ((size_t)(b * 36 + ck) * 2 + d) * 256 + ch;
    float H = 0.f, Ap = 1.f;
#pragma unroll
    for (int q = 0; q < 16; ++q) {
      const int pos = seg * 16 + q;
      const int tt = d == 0 ? pos : 63 - pos;
      const float a = AA[(d * 64 + tt) * 64 + j];
      H = a * H + BQ[(d * 64 + tt) * 64 + j];
      Ap *= a;
    }
    SEG[((seg * 2 + d) * 64 + j) * 2 + 0] = Ap;
    SEG[((seg * 2 + d) * 64 + j) * 2 + 1] = H;
    __syncthreads();
    if (!outmode) {
      if (seg == 0) {
        float Ht = 0.f, At = 1.f;
#pragma unroll
        for (int sgi = 0; sgi < 4; ++sgi) {
          const float as = SEG[((sgi * 2 + d) * 64 + j) * 2 + 0], hs = SEG[((sgi * 2 + d) * 64 + j) * 2 + 1];
          Ht = as * Ht + hs;
          At *= as;
        }
        agg[ci * 2 + 0] = At;
        agg[ci * 2 + 1] = Ht;
      }
    } else {
      float hc = car_pre;
      for (int sgi = 0; sgi < seg; ++sgi) {
        const float as = SEG[((sgi * 2 + d) * 64 + j) * 2 + 0], hs = SEG[((sgi * 2 + d) * 64 + j) * 2 + 1];
        hc = as * hc + hs;
      }
#pragma unroll
      for (int q = 0; q < 16; ++q) {
        const int pos = seg * 16 + q;
        const int tt = d == 0 ? pos : 63 - pos;
        const float a = AA[(d * 64 + tt) * 64 + j];
        hc = a * hc + BQ[(d * 64 + tt) * 64 + j];
        AA[(d * 64 + tt) * 64 + j] = hc;
      }
    }
  }
  __syncthreads();
  if (outmode) {
    const int ch = hh * 64 + lane;
    const float gm = p.in[24][(size_t)l * 1024 + 768 + ch];
#pragma unroll
    for (int q = 0; q < 8; ++q) {
      const int tt = w * 8 + q;
      const int row = rowbase + t0 + tt;
      const float hr = AA[tt * 64 + lane] + AA[(64 + tt) * 64 + lane];
      const float v = hr * gelu_tanh(gp_pre[q]);
      const float ss = wsum(v * v, lane);
      const float rn = rsqrtf(ss * (1.f / 64.f) + EPSF);
      y[(size_t)row * 1024 + 768 + ch] = f2bf(v * rn * gm);
    }
    __syncthreads();
  }
}

__device__ void rg_scan_phase(const Params& p) {
  const float* agg = (const float*)(p.ws + OFF_RGAGG);
  float* car = (float*)(p.ws + OFF_RGCAR);
  for (int tile = blockIdx.x; tile < 8; tile += gridDim.x) {
    const int gid = tile * 512 + opaque_tid();
    const int b = gid >> 9, d = (gid >> 8) & 1, ch = gid & 255;
    float2 ag[36];
#pragma unroll
    for (int i = 0; i < 36; ++i) {
      const int ck = (d == 0) ? i : (i < 4 ? 3 - i : 39 - i);
      const size_t ci = ((size_t)(b * 36 + ck) * 2 + d) * 256 + ch;
      ag[i] = *(const float2*)(agg + ci * 2);
    }
    float hcur = 0.f;
#pragma unroll
    for (int i = 0; i < 36; ++i) {
      const int ck = (d == 0) ? i : (i < 4 ? 3 - i : 39 - i);
      const size_t ci = ((size_t)(b * 36 + ck) * 2 + d) * 256 + ch;
      car[ci] = hcur;
      hcur = ag[i].x * hcur + ag[i].y;
    }
  }
}

__device__ void hy_prep_tile(unsigned char* lds, const Params& p, int l, int b, int ck) {
  bf16_t* uL = (bf16_t*)lds;
  const int tid = opaque_tid();
  const bf16_t* z = (const bf16_t*)(p.ws + OFF_A);
  bf16_t* uT = (bf16_t*)(p.ws + OFF_ACT);
  const bool isctx = ck < 4;
  const int L = isctx ? 256 : 2048;
  const int t0 = isctx ? ck * 64 : (ck - 4) * 64;
  const int rowbase = isctx ? (NLAT + b * 256) : (b * 2048);
  const int posoff = isctx ? 2048 : 0;
  {
    const int c = tid & 255, half = tid >> 8;
    const float* wc = p.in[9] + (size_t)l * 3 * 768;
    const float a0 = wc[256 + c], a1 = wc[768 + 256 + c], a2 = wc[1536 + 256 + c];
    const float v0 = wc[512 + c], v1 = wc[768 + 512 + c], v2 = wc[1536 + 512 + c];
    const int ts = t0 + half * 32;
    float xp, xc, xn, vp, vc, vn;
    { const int tq = ts - 1 >= 0 ? ts - 1 : 0; const float mk = ts - 1 >= 0 ? 1.f : 0.f;
      xp = mk * bf2f(z[(size_t)(rowbase + tq) * ZS + 256 + c]); vp = mk * bf2f(z[(size_t)(rowbase + tq) * ZS + 512 + c]); }
    xc = bf2f(z[(size_t)(rowbase + ts) * ZS + 256 + c]); vc = bf2f(z[(size_t)(rowbase + ts) * ZS + 512 + c]);
#pragma unroll 8
    for (int q = 0; q < 32; ++q) {
      const int tp = ts + q;
      { const int tq = tp + 1 < L ? tp + 1 : L - 1; const float mk = tp + 1 < L ? 1.f : 0.f;
        xn = mk * bf2f(z[(size_t)(rowbase + tq) * ZS + 256 + c]); vn = mk * bf2f(z[(size_t)(rowbase + tq) * ZS + 512 + c]); }
      const float x1 = a0 * xp + a1 * xc + a2 * xn;
      const float vv = v0 * vp + v1 * vc + v2 * vn;
      uL[c * 66 + half * 32 + q] = f2bf(x1 * vv);
      xp = xc; xc = xn; vp = vc; vc = vn;
    }
  }
  __syncthreads();
  {
    const int c = tid >> 1, hf = tid & 1;
    const unsigned* src = (const unsigned*)(uL + c * 66 + hf * 32);
    uint4* dst = (uint4*)(uT + ((size_t)c * 8 + b) * LTOT + posoff + t0 + hf * 32);
#pragma unroll
    for (int q = 0; q < 4; ++q) {
      uint4 u; u.x = src[q * 4 + 0]; u.y = src[q * 4 + 1]; u.z = src[q * 4 + 2]; u.w = src[q * 4 + 3];
      dst[q] = u;
    }
  }
  __syncthreads();
}

#define HY_OFF 2064
#define HY_CL 4128
__device__ void hy_conv_sub(unsigned char* lds, const Params& p, int l, int c, int L, int posoff) {
  bf16_t* cp = (bf16_t*)lds;
  bf16_t* uL = cp + 8 * HY_CL;
  const int tid = opaque_tid(), lane = tid & 63, w = tid >> 6, lr = lane & 15, lg = lane >> 4;
  const float* hf = (const float*)(p.ws + OFF_FILT) + ((size_t)(l * 256 + c) * 2 + 0) * LTOT + posoff;
  const float* hb = hf + LTOT;
  const bf16_t* uT = (const bf16_t*)(p.ws + OFF_ACT);
  bf16_t* ycv = (bf16_t*)(p.ws + OFF_YCV);
#pragma unroll 8
  for (int idx = tid; idx < 8 * HY_CL; idx += 512) {
    const int cc = idx / HY_CL, m = idx - cc * HY_CL;
    const int n = m - cc - HY_OFF;
    const int a = n <= 0 ? -n : n;
    const int ac = a < L ? a : L - 1;
    const float* base = (n <= 0) ? hf : hb;
    const float v = base[ac];
    cp[idx] = f2bf(a < L ? v : 0.f);
  }
  for (int idx = tid; idx < 8 * (L >> 3); idx += 512) {
    const int bb = idx / (L >> 3), q = idx - bb * (L >> 3);
    *(uint4*)(uL + bb * 2048 + q * 8) = *(const uint4*)(uT + ((size_t)c * 8 + bb) * LTOT + posoff + q * 8);
  }
  __syncthreads();
  const float bias = p.in[17][l * 256 + c];
  const int ngroups = L >> 7, ksteps = L >> 5;
  for (int g = w; g < ngroups; g += 8) {
    f32x4 acc[8];
#pragma unroll
    for (int i = 0; i < 8; ++i) acc[i] = (f32x4){0.f, 0.f, 0.f, 0.f};
    const bf16_t* abase = cp + (lr & 7) * HY_CL + HY_OFF + 8 * lg - 8 * (lr >> 3) - 128 * g;
    const bf16_t* bbase = uL + (lr & 7) * 2048 + lg * 8;
    bf16x8 a[8];
#pragma unroll
    for (int mi = 2; mi < 8; ++mi) a[(-mi) & 7] = ldfrag(abase - 16 * mi);
    for (int ks4 = 0; ks4 < ksteps; ks4 += 4) {
#pragma unroll
      for (int j = 0; j < 4; ++j) {
        const int ks = ks4 + j;
        a[(2 * j) & 7] = ldfrag(abase + ks * 32);
        a[(2 * j - 1) & 7] = ldfrag(abase + ks * 32 - 16);
        const bf16x8 bfr = ldfrag(bbase + ks * 32);
#pragma unroll
        for (int mi = 0; mi < 8; ++mi) acc[mi] = mfma16(a[(2 * j - mi) & 7], bfr, acc[mi]);
      }
    }
    if (lr < 8) {
#pragma unroll
      for (int mi = 0; mi < 8; ++mi) {
        const int tb = 128 * g + 16 * mi + 4 * lg;
        float o[4];
#pragma unroll
        for (int j = 0; j < 4; ++j) o[j] = acc[mi][j] + bf2f(uL[lr * 2048 + tb + j]) * bias;
        uint2 u; u.x = pack2(o[0], o[1]); u.y = pack2(o[2], o[3]);
        *(uint2*)(ycv + ((size_t)c * 8 + lr) * LTOT + posoff + tb) = u;
      }
    }
  }
  __syncthreads();
}

__device__ void hy_merge_tile(unsigned char* lds, const Params& p, int l, int b, int ck) {
  bf16_t* yL = (bf16_t*)lds;
  const int tid = opaque_tid(), lane = tid & 63, w = tid >> 6;
  const bf16_t* z = (const bf16_t*)(p.ws + OFF_A);
  const bf16_t* ycv = (const bf16_t*)(p.ws + OFF_YCV);
  bf16_t* y = (bf16_t*)(p.ws + OFF_ACT);
  const bool isctx = ck < 4;
  const int L = isctx ? 256 : 2048;
  const int t0 = isctx ? ck * 64 : (ck - 4) * 64;
  const int rowbase = isctx ? (NLAT + b * 256) : (b * 2048);
  const int posoff = isctx ? 2048 : 0;
#pragma unroll
  for (int i = 0; i < 4; ++i) {
    const int id = tid + 512 * i;
    const int c = id >> 3, q = id & 7;
    *(uint4*)(yL + c * 72 + q * 8) = *(const uint4*)(ycv + ((size_t)c * 8 + b) * LTOT + posoff + t0 + q * 8);
  }
  __syncthreads();
  const float* wc = p.in[9] + (size_t)l * 3 * 768;
  const float* gm = p.in[24] + (size_t)l * 1024;
#pragma unroll 4
  for (int q = 0; q < 8; ++q) {
    const int tt = w + 8 * q;
    const int tp = t0 + tt;
#pragma unroll
    for (int gi = 0; gi < 4; ++gi) {
      const int c = gi * 64 + lane;
      const int tm1 = tp - 1 >= 0 ? tp - 1 : 0, tp1 = tp + 1 < L ? tp + 1 : L - 1;
      const float za = bf2f(z[(size_t)(rowbase + tm1) * ZS + c]);
      const float zb = bf2f(z[(size_t)(rowbase + tp) * ZS + c]);
      const float zc = bf2f(z[(size_t)(rowbase + tp1) * ZS + c]);
      float x0 = wc[768 + c] * zb;
      x0 += (tp - 1 >= 0 ? wc[c] : 0.f) * za;
      x0 += (tp + 1 < L ? wc[1536 + c] : 0.f) * zc;
      const float v = x0 * bf2f(yL[c * 72 + tt]);
      const float ss = wsum(v * v, lane);
      const float rn = rsqrtf(ss * (1.f / 64.f) + EPSF);
      y[(size_t)(rowbase + tp) * 1024 + c] = f2bf(v * rn * gm[c]);
    }
  }
  __syncthreads();
}

__global__ void __launch_bounds__(512) fwd_kernel(Params p) {
  extern __shared__ __attribute__((aligned(16))) unsigned char lds[];
  cg::grid_group grid = cg::this_grid();
  const int G_ = gridDim.x;
  if (threadIdx.x == 0) *(uint4*)(lds + LDS_XB) = make_uint4(0u, 0u, 0u, 0u);
  __syncthreads();
  XcdBarrier xb = xcd_barrier_post((unsigned*)(p.ws + OFF_BAR), (volatile LAS unsigned*)(lds + LDS_XB));
  unsigned char* ws = p.ws;
  bf16_t* act = (bf16_t*)(ws + OFF_ACT);
  bf16_t* zbuf = (bf16_t*)(ws + OFF_A);
  bf16_t* hid_lat = (bf16_t*)(ws + OFF_A);
  bf16_t* hid_ctx = (bf16_t*)(ws + OFF_ST);
  float* ctxs = (float*)(ws + OFF_CTXS);
  float* cpart = (float*)(ws + OFF_ST + 16 * MiB);
  const float* modall = (const float*)(ws + OFF_MOD);

  mods_phase(lds, p);
  if (p.ws == nullptr) grid.sync();
  GSYNC();

#pragma unroll 1
  for (int l = 0; l < 2; ++l) {
    const bool need_ctx = (l == 0);
    const float* xin = (l == 0) ? p.in[0] : p.out;
    const float* cin = (l == 0) ? p.in[2] : ctxs;
    const float* modl = modall + (size_t)l * 9 * 6144;
    norm_phase<3, true>(lds, p, l, xin, cin, (l == 1) ? cpart : nullptr, p.in[6] + l * 1024, 0, NROW);
    if (l == 1 && G_ != 256) convert_w1_w2(lds, p, 1, blockIdx.x, G_);
    if (l == 0) {
      for (int rep = 0; rep < REP_P0; ++rep) {
        convert_win_wout(lds, p, 0, blockIdx.x, G_);
        if (G_ <= 64) convert_w1_w2(lds, p, 0, blockIdx.x, G_);
        filters_phase(lds, p);
        rgw_phase(p);
      }
    }
    GSYNC();
    for (int rep = 0; rep < REP_P2; ++rep)
    gemm_phase(lds, act, act + (size_t)NLAT * 1024, 1024, (const bf16_t*)(ws + OFF_WIN), 1024, 72, 13, 1,
               [=](int m, int n, f32x4 v, f32x4 w, int) {
                 uint4 u; u.x = pack2(v[0], v[1]); u.y = pack2(v[2], v[3]); u.z = pack2(w[0], w[1]); u.w = pack2(w[2], w[3]);
                 *(uint4*)(zbuf + (size_t)m * ZS + n) = u;
               });
    if (l == 1 && G_ == 256 && (int)blockIdx.x >= 168) convert_w1_w2(lds, p, 1, (int)blockIdx.x - 168, 88, 1024);
    GSYNC();
    for (int rep = 0; rep < REP_P3; ++rep) {
    for (int item = blockIdx.x; item < 576 + 1152 + 288; item += G_) {
      if (item < 576) {
        const int n = item % 18, bh = item / 18;
        ml_local_tile(lds, p, l, bh >> 2, bh & 3, n);
      } else if (item < 576 + 1152) {
        const int tile = item - 576;
        const int hh = tile & 3, ck = (tile >> 2) % 36, b = tile / 144;
        rg_tile(lds, p, l, b, ck, hh, false);
      } else {
        const int tile = item - 576 - 1152;
        hy_prep_tile(lds, p, l, tile / 36, tile % 36);
      }
    }
    }
    if (l == 1 && G_ == 256 && (int)blockIdx.x >= 64) convert_w1_w2(lds, p, 1, 1024 + (int)blockIdx.x - 64, 192, 2048);
    GSYNC();
    for (int rep = 0; rep < REP_HYC; ++rep)
    for (int c = blockIdx.x; c < 256; c += G_) {
      hy_conv_sub(lds, p, l, c, 2048, 0);
      if (need_ctx) hy_conv_sub(lds, p, l, c, 256, 2048);
    }
    ml_scan_phase(p);
    rg_scan_phase(p);
    GSYNC();
    {
      const int nfirst = need_ctx ? 0 : 2, ncnt = 18 - nfirst;
      const int cfirst = need_ctx ? 0 : 4, ccnt = 36 - cfirst;
      const int n_ml = 32 * ncnt, n_rg = 32 * ccnt, n_hy = 8 * ccnt;
      for (int item0 = blockIdx.x; item0 < REP_P5 * (REP_ML * n_ml + REP_RG * n_rg + n_hy); item0 += G_) {
        int item = (REP_P5 > 1) ? item0 % (n_ml + n_rg + n_hy) : item0;
        if (REP_ML > 1) item = (item0 < REP_ML * n_ml) ? item0 % n_ml : item0 - (REP_ML - 1) * n_ml;
        if (REP_RG > 1) item = (item0 < n_ml) ? item0 : ((item0 < n_ml + REP_RG * n_rg) ? n_ml + (item0 - n_ml) % n_rg : item0 - (REP_RG - 1) * n_rg);
        if (item < n_ml) {
          const int n = nfirst + item % ncnt, bh = item / ncnt;
          ml_out_tile(lds, p, l, bh >> 2, bh & 3, n);
        } else if (item < n_ml + n_rg) {
          const int tile = item - n_ml;
          const int hh = tile & 3, ck = cfirst + (tile >> 2) % ccnt, b = tile / (4 * ccnt);
          rg_tile(lds, p, l, b, ck, hh, true);
        } else {
          const int tile = item - n_ml - n_rg;
          hy_merge_tile(lds, p, l, tile / ccnt, cfirst + tile % ccnt);
        }
      }
      if (l == 0 && G_ > 64 && (int)blockIdx.x >= 64) {
        if (G_ == 256) convert_w1_w2(lds, p, 0, (int)blockIdx.x - 64, 192, 512);
        else convert_w1_w2(lds, p, 0, (int)blockIdx.x - 64, G_ - 64);
      }
    }
    GSYNC();
    const int mt_res = need_ctx ? 72 : 64;
    {
      const float* cres = cin;
      gemm_phase(lds, act, act + (size_t)NLAT * 1024, 1024, (const bf16_t*)(ws + OFF_WOUT), 1024, mt_res, 4, 1,
                 [=](int m, int n, f32x4 v, f32x4 w, int) {
                   const float* src; float* dst; const float* g;
                   if (m < NLAT) { src = xin + (size_t)m * 1024 + n; dst = p.out + (size_t)m * 1024 + n; g = modl + (size_t)(m >> 11) * 6144 + 2 * 1024 + n; }
                   else { src = cres + (size_t)(m - NLAT) * 1024 + n; dst = ctxs + (size_t)(m - NLAT) * 1024 + n; g = modl + (size_t)8 * 6144 + 2 * 1024 + n; }
                   const float4 s4 = *(const float4*)src; const float4 g4 = *(const float4*)g;
                   const float4 s5 = *(const float4*)(src + 4); const float4 g5 = *(const float4*)(g + 4);
                   float4 o; o.x = s4.x + g4.x * v[0]; o.y = s4.y + g4.y * v[1]; o.z = s4.z + g4.z * v[2]; o.w = s4.w + g4.w * v[3];
                   float4 o2; o2.x = s5.x + g5.x * w[0]; o2.y = s5.y + g5.y * w[1]; o2.z = s5.z + g5.z * w[2]; o2.w = s5.w + g5.w * w[3];
                   *(float4*)dst = o; *(float4*)(dst + 4) = o2;
                 });
    }
    if (l == 0 && G_ == 256 && (int)blockIdx.x >= 32) convert_w1_w2(lds, p, 0, 512 + (int)blockIdx.x - 32, 224, 2048);
    GSYNC();
    if (need_ctx) norm_phase<3, false>(lds, p, l, p.out, ctxs, nullptr, p.in[7] + l * 1024, 3, NROW);
    else norm_phase<4, false>(lds, p, l, p.out, ctxs, nullptr, p.in[7] + l * 1024, 3, NLAT);
    if (l == 0 && G_ != 256) convert_win_wout(lds, p, 1, blockIdx.x, G_);
    GSYNC();
    for (int rep = 0; rep < REP_P8; ++rep)
    gemm_phase(lds, act, act + (size_t)NLAT * 1024, 1024, (const bf16_t*)(ws + OFF_W1), 1024, mt_res, 16, 1,
               [=](int m, int n, f32x4 v, f32x4 w, int) {
                 float r0 = fmaxf(v[0], 0.f), r1 = fmaxf(v[1], 0.f), r2 = fmaxf(v[2], 0.f), r3 = fmaxf(v[3], 0.f);
                 float r4 = fmaxf(w[0], 0.f), r5 = fmaxf(w[1], 0.f), r6 = fmaxf(w[2], 0.f), r7 = fmaxf(w[3], 0.f);
                 uint4 u; u.x = pack2(r0 * r0, r1 * r1); u.y = pack2(r2 * r2, r3 * r3); u.z = pack2(r4 * r4, r5 * r5); u.w = pack2(r6 * r6, r7 * r7);
                 bf16_t* dst = (m < NLAT) ? (hid_lat + (size_t)m * 4096 + n) : (hid_ctx + (size_t)(m - NLAT) * 4096 + n);
                 *(uint4*)dst = u;
               });
    if (l == 0 && G_ == 256 && (int)blockIdx.x >= 128) convert_win_wout(lds, p, 1, (int)blockIdx.x - 128, 128);
    GSYNC();
    gemm_phase(lds, hid_lat, hid_ctx, 4096, (const bf16_t*)(ws + OFF_W2), 4096, mt_res, 4, 3,
               [=](int m, int n, f32x4 v, f32x4 w, int piece) {
                 float* dst; const float* g;
                 if (m < NLAT) { dst = p.out + (size_t)m * 1024 + n; g = modl + (size_t)(m >> 11) * 6144 + 5 * 1024 + n; }
                 else { dst = ((piece == 0) ? ctxs : (cpart + (size_t)(piece - 1) * 2048 * 1024)) + (size_t)(m - NLAT) * 1024 + n; g = modl + (size_t)8 * 6144 + 5 * 1024 + n; }
                 const float4 g4 = *(const float4*)g; const float4 g5 = *(const float4*)(g + 4);
                 float4 o; o.x = g4.x * v[0]; o.y = g4.y * v[1]; o.z = g4.z * v[2]; o.w = g4.w * v[3];
                 float4 o2; o2.x = g5.x * w[0]; o2.y = g5.y * w[1]; o2.z = g5.z * w[2]; o2.w = g5.w * w[3];
                 if (piece == 0) {
                   const float4 s4 = *(const float4*)dst; const float4 s5 = *(const float4*)(dst + 4);
                   o.x += s4.x; o.y += s4.y; o.z += s4.z; o.w += s4.w; o2.x += s5.x; o2.y += s5.y; o2.z += s5.z; o2.w += s5.w;
                 }
                 *(float4*)dst = o; *(float4*)(dst + 4) = o2;
               });
    GSYNC();
  }
  final_norm_phase(p);
}

extern "C" void kernel_launch(void* const* d_in, const int* in_sizes, int n_in, void* d_out, int out_size, void* d_ws,
                              size_t ws_size, hipStream_t stream) {
  static int grid_blocks = 0;
  if (!grid_blocks) {
    int dev = 0, cus = 0, per_cu = 0;
    hipGetDevice(&dev);
    hipDeviceGetAttribute(&cus, hipDeviceAttributeMultiprocessorCount, dev);
    hipFuncSetAttribute((const void*)fwd_kernel, hipFuncAttributeMaxDynamicSharedMemorySize, LDS_BYTES);
    hipOccupancyMaxActiveBlocksPerMultiprocessor(&per_cu, (const void*)fwd_kernel, 512, LDS_BYTES);
    if (per_cu < 1) { fprintf(stderr, "occupancy query returned %d\n", per_cu); per_cu = 1; }
    if (per_cu > 1) per_cu = 1;
    grid_blocks = cus * per_cu;
    if (ws_size < OFF_END) fprintf(stderr, "workspace too small: %zu < %zu\n", ws_size, (size_t)OFF_END);
  }
  hipMemsetAsync((unsigned char*)d_ws + OFF_BAR, 0, XCD_BAR_WORDS * 4, stream);
  Params p{};
  for (int i = 0; i < 29; ++i) p.in[i] = (const float*)d_in[i];
  p.out = (float*)d_out;
  p.ws = (unsigned char*)d_ws;
  void* args[] = {&p};
  hipError_t e = hipLaunchCooperativeKernel((const void*)fwd_kernel, dim3(grid_blocks), dim3(512), args, LDS_BYTES, stream);
  if (e != hipSuccess) fprintf(stderr, "cooperative launch failed: %s (grid %d)\n", hipGetErrorString(e), grid_blocks);
}
```

```cpp
#include <hip/hip_runtime.h>
#include <hip/hip_cooperative_groups.h>
#include <cstdio>
namespace cg = cooperative_groups;

typedef unsigned short bf16_t;
using bf16x8 = __attribute__((ext_vector_type(8))) short;
using f32x4 = __attribute__((ext_vector_type(4))) float;

#define NLAT 16384
#define NROW 18432
#define ZS 3328
#define LTOT 2304
#define EPSF 1e-6f

constexpr size_t MiB = 1048576;
constexpr size_t OFF_A = 0;
constexpr size_t OFF_YCV = 117 * MiB;
constexpr size_t OFF_ACT = 128 * MiB;
constexpr size_t OFF_ST = 164 * MiB;
constexpr size_t OFF_W = 200 * MiB;
constexpr size_t OFF_WIN = OFF_W;
constexpr size_t OFF_WOUT = OFF_WIN + (size_t)3328 * 1024 * 2;
constexpr size_t OFF_W1 = OFF_WOUT + 2 * MiB;
constexpr size_t OFF_W2 = OFF_W1 + 8 * MiB;
constexpr size_t OFF_CTXS = OFF_W2 + 8 * MiB;
constexpr size_t OFF_FILT = OFF_CTXS + 8 * MiB;
constexpr size_t OFF_G = OFF_FILT + 9 * MiB;
constexpr size_t OFF_MOD = OFF_G + (size_t)NROW * 16 * 4;
constexpr size_t OFF_NST = OFF_MOD + (size_t)2 * 9 * 6144 * 4;
constexpr size_t OFF_SCAL = OFF_NST + (size_t)1152 * 128 * 4;
constexpr size_t OFF_RGAGG = OFF_SCAL + 16384;
constexpr size_t OFF_RGCAR = OFF_RGAGG + (size_t)8 * 36 * 2 * 256 * 2 * 4;
constexpr size_t OFF_BAR = OFF_RGCAR + (size_t)8 * 36 * 2 * 256 * 4;
constexpr size_t OFF_RGW = OFF_BAR + 16384;
constexpr size_t OFF_END = OFF_RGW + (size_t)2 * 16 * 4096 * 2;
static_assert(OFF_END <= 256 * MiB, "workspace");

constexpr int LDS_XB = 149504;
constexpr int LDS_BYTES = 149504 + 16;
#define REP_P0 1
#define REP_NORM 1
#define REP_P2 1
#define REP_P3 1
#define REP_HYC 1
#define REP_P5 1
#define REP_P8 1
#define REP_SYNC 1
#define REP_ML 1
#define REP_RG 1
#define GSYNC() do { for (int rs_ = 0; rs_ < REP_SYNC; ++rs_) xcd_barrier(xb); } while (0)


struct Params {
  const float* in[29];
  float* out;
  unsigned char* ws;
};

__device__ __forceinline__ int opaque_tid() { int t = threadIdx.x; asm volatile("" : "+v"(t)); return t; }
typedef __bf16 hwbf16x2_t __attribute__((ext_vector_type(2)));
typedef float hwf32x2_t __attribute__((ext_vector_type(2)));
__device__ __forceinline__ unsigned pack2(float a, float b) {
  hwf32x2_t v = {a, b};
  hwbf16x2_t r = __builtin_convertvector(v, hwbf16x2_t);
  return __builtin_bit_cast(unsigned, r);
}
__device__ __forceinline__ bf16_t f2bf(float f) { return (bf16_t)(pack2(f, 0.f) & 0xffffu); }
__device__ __forceinline__ float bf2f(bf16_t h) { return __uint_as_float(((unsigned)h) << 16); }
__device__ __forceinline__ float lo16(unsigned u) { return __uint_as_float(u << 16); }
__device__ __forceinline__ float hi16(unsigned u) { return __uint_as_float(u & 0xffff0000u); }
__device__ __forceinline__ void unpack8(uint4 u, float* f) {
  f[0] = lo16(u.x); f[1] = hi16(u.x); f[2] = lo16(u.y); f[3] = hi16(u.y);
  f[4] = lo16(u.z); f[5] = hi16(u.z); f[6] = lo16(u.w); f[7] = hi16(u.w);
}
__device__ __forceinline__ uint4 pack8(const float* f) {
  uint4 u; u.x = pack2(f[0], f[1]); u.y = pack2(f[2], f[3]); u.z = pack2(f[4], f[5]); u.w = pack2(f[6], f[7]); return u;
}
__device__ __forceinline__ float shfl_idx(float v, int srclane) {
  return __builtin_bit_cast(float, __builtin_amdgcn_ds_bpermute(srclane << 2, __builtin_bit_cast(int, v)));
}
__device__ __forceinline__ float wsum(float v, int lane) {
#pragma unroll
  for (int o = 32; o > 0; o >>= 1) v += shfl_idx(v, lane ^ o);
  return v;
}
__device__ __forceinline__ float fexp(float x) { return __expf(x); }
__device__ __forceinline__ float frcp(float x) { return __builtin_amdgcn_rcpf(x); }
__device__ __forceinline__ float sigm(float x) { return frcp(1.f + fexp(-x)); }
__device__ __forceinline__ float siluf(float x) { return x * frcp(1.f + fexp(-x)); }
__device__ __forceinline__ float logsig(float x) { return fminf(x, 0.f) - __logf(1.f + fexp(-fabsf(x))); }
__device__ __forceinline__ float softplusf(float x) { return fmaxf(x, 0.f) + __logf(1.f + fexp(-fabsf(x))); }
__device__ __forceinline__ float gelu_tanh(float x) {
  const float u = 0.7978845608028654f * (x + 0.044715f * x * x * x);
  const float th = 1.f - 2.f * frcp(fexp(2.f * u) + 1.f);
  return 0.5f * x * (1.f + th);
}
__device__ __forceinline__ f32x4 mfma16(bf16x8 a, bf16x8 b, f32x4 c) {
  return __builtin_amdgcn_mfma_f32_16x16x32_bf16(a, b, c, 0, 0, 0);
}
__device__ __forceinline__ bf16x8 ldfrag(const bf16_t* p) { return *(const bf16x8*)p; }


#define XB_TMO      128
#define XB_XCNT(j)  (256  + 64 * (j))
#define XB_XSUB(j)  (1280 + 64 * (j))
#define XB_XGEN(j)  (2304 + 64 * (j))
#define XB_TOP      3328
#define XB_TOPGEN   3392
#define XCD_BAR_WORDS 3456
#define XB_SPIN_CAP (1u << 18)
#define LAS __attribute__((address_space(3)))
__device__ __forceinline__ unsigned xb_ld(unsigned* p)              { return __hip_atomic_load(p, __ATOMIC_RELAXED, __HIP_MEMORY_SCOPE_AGENT); }
__device__ __forceinline__ unsigned xb_add(unsigned* p, unsigned v) { return __hip_atomic_fetch_add(p, v, __ATOMIC_RELAXED, __HIP_MEMORY_SCOPE_AGENT); }
__device__ __forceinline__ unsigned xb_xcc_id() { return (unsigned)__builtin_amdgcn_s_getreg((3 << 11) | 20) & 0xFu; }
#define XB_SPIN(cond, bar) do { unsigned _sp = 0; while (cond) { __builtin_amdgcn_s_sleep(1); \
    if ((++_sp & 255u) == 0u) { if (xb_ld(&(bar)[XB_TMO])) break; if (_sp > XB_SPIN_CAP) { atomicAdd(&(bar)[XB_TMO], 1u); break; } } } } while (0)
struct XcdBarrier { unsigned* bar; unsigned x; volatile LAS unsigned* st; };
__device__ __forceinline__ XcdBarrier xcd_barrier_post(unsigned* bar, volatile LAS unsigned* st) {
    XcdBarrier b; b.bar = bar; b.x = xb_xcc_id(); b.st = st;
    if (threadIdx.x == 0) (void)xb_add(&bar[XB_XCNT(b.x)], 1u);
    return b;
}
__device__ __forceinline__ void xcd_barrier_complete(unsigned* bar, unsigned x, unsigned& nloc, unsigned& nx) {
    const unsigned G = gridDim.x * gridDim.y * gridDim.z;
    unsigned sum, cnt, mine, sp = 0u;
    for (;;) {
        sum = 0u; cnt = 0u; mine = 0u;
#pragma unroll
        for (unsigned j = 0; j < 16; ++j) { const unsigned c = xb_ld(&bar[XB_XCNT(j)]); sum += c; cnt += (c > 0u) ? 1u : 0u; mine = (j == x) ? c : mine; }
        if (sum == G) break;
        __builtin_amdgcn_s_sleep(1);
        if ((++sp & 255u) == 0u) { if (xb_ld(&bar[XB_TMO])) break; if (sp > XB_SPIN_CAP) { atomicAdd(&bar[XB_TMO], 1u); break; } }
    }
    nloc = mine > 0u ? mine : 1u; nx = cnt > 0u ? cnt : 1u;
}
__device__ __forceinline__ void xcd_barrier(const XcdBarrier& b) {
    asm volatile("s_waitcnt vmcnt(0)" ::: "memory");
    __syncthreads();
    if (threadIdx.x == 0) {
        unsigned* bar = b.bar;
        __builtin_amdgcn_s_waitcnt(0);
        unsigned nloc = b.st[0], nx = b.st[1];
        if (nloc == 0u) { xcd_barrier_complete(bar, b.x, nloc, nx); b.st[0] = nloc; b.st[1] = nx; }
        const unsigned old = xb_add(&bar[XB_XSUB(b.x)], 1u);
        const unsigned gen = old / nloc;
        if (old + 1u == (gen + 1u) * nloc) {
            __builtin_amdgcn_fence(__ATOMIC_RELEASE, "agent");
            asm volatile("s_waitcnt vmcnt(0)" ::: "memory");
            const unsigned og = xb_add(&bar[XB_TOP], 1u);
            const unsigned tg = og / nx;
            if (og + 1u == (tg + 1u) * nx) xb_add(&bar[XB_TOPGEN], 1u);
            else XB_SPIN(xb_ld(&bar[XB_TOPGEN]) == tg, bar);
            __builtin_amdgcn_fence(__ATOMIC_ACQUIRE, "agent");
            xb_add(&bar[XB_XGEN(b.x)], 1u);
            asm volatile("s_waitcnt vmcnt(0)" ::: "memory");
        } else {
            XB_SPIN(xb_ld(&bar[XB_XGEN(b.x)]) == gen, bar);
            __builtin_amdgcn_fence(__ATOMIC_ACQUIRE, "agent");
            asm volatile("s_waitcnt vmcnt(0)" ::: "memory");
        }
    }
    __syncthreads();
}

__device__ __forceinline__ int g8_lds_byte(int r, int c) {
  int st = (r >> 4) * 2 + (c >> 5), rr = r & 15, cc = c & 31, ob = rr * 64 + cc * 2;
  return st * 1024 + (ob ^ (((ob >> 9) & 1) << 5));
}
__device__ __forceinline__ void g8_stage_rc(int b, int& R, int& C) {
  int st = b / 1024, sb = b % 1024, swz = sb ^ (((sb >> 9) & 1) << 5);
  R = (st >> 1) * 16 + swz / 64; C = (st & 1) * 32 + (swz % 64) / 2;
}
struct GUnit { int brow, bcol, kst, nt, piece; };
template <class Epi>
__device__ __forceinline__ void gemm_phase(unsigned char* lds_g, const bf16_t* A0, const bf16_t* A1, int lda, const bf16_t* Bt, int K,
                           int mtiles, int ntiles, int ksplit, Epi epi) {
  (void)lda;
  constexpr int BK = 64, HALF = 128, HTB = HALF * BK * 2;
  constexpr bool G_SP2 = true, G_ALIGN = true;
  LAS unsigned char* lds = (LAS unsigned char*)lds_g;
  const int tid = opaque_tid(), wid = __builtin_amdgcn_readfirstlane(tid >> 6), lane = tid & 63, wr = wid >> 2, wc = wid & 3, fr = lane & 15, fq = lane >> 4;
  const int lat_items = (mtiles < 64 ? mtiles : 64) * ntiles;
  const int ntl = lat_items + (mtiles - (mtiles < 64 ? mtiles : 64)) * ntiles * ksplit;
  const int nt_all = K / BK;
  const int piece_steps = (ksplit == 1) ? nt_all : (((nt_all + ksplit - 1) / ksplit + 1) & ~1);
  const int G8 = gridDim.x >> 3;
  const int vb = ((gridDim.x & 7) == 0) ? ((blockIdx.x & 7) * G8 + (blockIdx.x >> 3)) : blockIdx.x;
  auto get_unit = [&](int i, GUnit& u) -> bool {
    if (ksplit == 1) {
      const int nwg = mtiles * ntiles, L = i * (int)gridDim.x + (int)blockIdx.x;
      if (L >= nwg) return false;
      int wgid = L; { const int q = nwg / 8, r = nwg % 8, xcd = wgid % 8, off = wgid / 8; wgid = (xcd < r ? xcd * (q + 1) : r * (q + 1) + (xcd - r) * q) + off; }
      const int nig = 4 * ntiles, gid = wgid / nig, fm = gid * 4, gsz = (mtiles - fm) < 4 ? (mtiles - fm) : 4;
      const int pm = fm + ((wgid % nig) % gsz), pn = (wgid % nig) / gsz;
      u.piece = 0; u.kst = 0; u.nt = nt_all; u.brow = pm * 256; u.bcol = pn * 256;
      return true;
    }
    const int item = (i == 0 ? vb : (int)blockIdx.x) + i * (int)gridDim.x;
    if (item >= ntl) return false;
    int tile = item; u.piece = 0;
    if (item >= lat_items) { const int c_ = item - lat_items; tile = lat_items + c_ / ksplit; u.piece = c_ - (c_ / ksplit) * ksplit; }
    u.kst = u.piece * piece_steps;
    u.nt = (item < lat_items) ? nt_all : ((nt_all - u.kst < piece_steps) ? (nt_all - u.kst) : piece_steps);
    const int pm = tile / ntiles, pn = tile - pm * ntiles;
    u.brow = pm * 256; u.bcol = pn * 256;
    return true;
  };
  unsigned voff[2], voffB[2];
#pragma unroll
  for (int i = 0; i < 2; ++i) {
    int R, C; g8_stage_rc(tid * 16 + i * 8192, R, C);
    const int rho = R & 31, Rb = (R & ~31) + 8 * ((rho & 15) >> 2) + 4 * (rho >> 4) + (rho & 3);
    voff[i] = (unsigned)(R * K + C) * 2u; voffB[i] = (unsigned)(Rb * K + C) * 2u;
  }
  const size_t kstep = (size_t)(BK * 2);
  const size_t hstep = (size_t)HALF * K * 2;
  const unsigned ldsw = (unsigned)wid * 1024u;
  const int aoff = g8_lds_byte(wr * 64 + fr, fq * 8), boff = g8_lds_byte(wc * 32 + fr, fq * 8);
#define PG8_SA(b, h) (((b) * 2 + (h)) * HTB)
#define PG8_SB(b, h) ((4 + (b) * 2 + (h)) * HTB)
#define PG8_STAGE_(bufoff, gbase, vo) do { _Pragma("unroll") for (int _i = 0; _i < 2; ++_i) \
        __builtin_amdgcn_global_load_lds((const unsigned*)((const char*)(gbase) + (vo)[_i]), (LAS unsigned*)(lds + (bufoff) + ldsw + _i * 8192), 16, 0, 0); } while (0)
#define PG8_STAGE(bufoff, gbase) PG8_STAGE_(bufoff, gbase, voff)
#define PG8_STAGEB(bufoff, gbase) PG8_STAGE_(bufoff, gbase, voffB)
#define PG8_LDA(dst, b, h) do { _Pragma("unroll") for (int m = 0; m < 4; ++m) _Pragma("unroll") for (int k = 0; k < 2; ++k) dst[m][k] = *(const LAS bf16x8*)(lds + PG8_SA(b, h) + aoff + m * 2048 + k * 1024); } while (0)
#define PG8_LDB(dst, b, h) do { _Pragma("unroll") for (int n = 0; n < 2; ++n) _Pragma("unroll") for (int k = 0; k < 2; ++k) dst[n][k] = *(const LAS bf16x8*)(lds + PG8_SB(b, h) + boff + n * 2048 + k * 1024); } while (0)
#define PG8_MMA(ai, bj, At, Bt_) do { __builtin_amdgcn_s_setprio(1); _Pragma("unroll") for (int m = 0; m < 4; ++m) _Pragma("unroll") for (int n = 0; n < 2; ++n) _Pragma("unroll") for (int k = 0; k < 2; ++k) \
        acc[ai][bj][m][n] = __builtin_amdgcn_mfma_f32_16x16x32_bf16(Bt_[n][k], At[m][k], acc[ai][bj][m][n], 0, 0, 0); __builtin_amdgcn_s_setprio(0); } while (0)
#define PG8_WAIT_V(n) asm volatile("s_waitcnt vmcnt(" #n ")" ::: "memory")
#define PG8_WAIT_L(n) asm volatile("s_waitcnt lgkmcnt(" #n ")" ::: "memory")
#define PG8_BAR __builtin_amdgcn_s_barrier()
#define PG8_SCHED __builtin_amdgcn_sched_barrier(0)
#define PG8_APTR(u) ((const char*)(((u).brow < NLAT) ? (A0 + (size_t)(u).brow * K) : (A1 + (size_t)((u).brow - NLAT) * K)) + (size_t)(u).kst * kstep)
#define PG8_BPTR(u) ((const char*)(Bt + (size_t)(u).bcol * K) + (size_t)(u).kst * kstep)
  GUnit cur, nxt; int ui = 0;
  if (get_unit(0, cur)) {
    f32x4 acc[2][2][4][2];
#pragma unroll
    for (int a = 0; a < 2; ++a)
#pragma unroll
      for (int b = 0; b < 2; ++b)
#pragma unroll
        for (int m = 0; m < 4; ++m)
#pragma unroll
          for (int n = 0; n < 2; ++n) acc[a][b][m][n] = (f32x4){0.f, 0.f, 0.f, 0.f};
    bf16x8 At[4][2], B0[2][2], B1[2][2];
    const char* cA = PG8_APTR(cur); const char* cB = PG8_BPTR(cur);
    if (G_SP2) {
      PG8_STAGEB(PG8_SB(0, 0), cB); PG8_STAGEB(PG8_SB(0, 1), cB + hstep); PG8_STAGE(PG8_SA(0, 0), cA); PG8_STAGE(PG8_SA(0, 1), cA + hstep);
      if (wr == 1) PG8_BAR;
      PG8_WAIT_V(2); PG8_BAR;
      PG8_STAGEB(PG8_SB(1, 0), cB + kstep); PG8_STAGE(PG8_SA(1, 0), cA + kstep); PG8_STAGEB(PG8_SB(1, 1), cB + hstep + kstep);
      PG8_WAIT_V(6); PG8_BAR;
    } else {
      PG8_STAGEB(PG8_SB(0, 0), cB); PG8_STAGE(PG8_SA(0, 0), cA); PG8_STAGEB(PG8_SB(0, 1), cB + hstep); PG8_STAGE(PG8_SA(0, 1), cA + hstep);
      if (wr == 1) PG8_BAR;
      PG8_WAIT_V(4); PG8_BAR;
      PG8_STAGEB(PG8_SB(1, 0), cB + kstep); PG8_STAGE(PG8_SA(1, 0), cA + kstep); PG8_STAGEB(PG8_SB(1, 1), cB + hstep + kstep);
      PG8_WAIT_V(6); PG8_BAR;
    }
    for (;;) {
      const bool has_next = get_unit(ui + 1, nxt);
      const char* nA = has_next ? PG8_APTR(nxt) : cA; const char* nB = has_next ? PG8_BPTR(nxt) : cB;
      const int nt = cur.nt;
      for (int t = 0; t < nt; t += 2) {
        const bool last = (t == nt - 2);
        const char* a1 = cA + (size_t)(t + 1) * kstep;
        const char* a2 = last ? nA : cA + (size_t)(t + 2) * kstep; const char* b2 = last ? nB : cB + (size_t)(t + 2) * kstep;
        const char* a3 = a2 + kstep; const char* b3 = b2 + kstep;
        if (G_SP2) {
        PG8_LDB(B0, 0, 0); PG8_LDB(B1, 0, 1); PG8_SCHED; PG8_LDA(At, 0, 0); PG8_STAGE(PG8_SA(1, 1), a1 + hstep);
        PG8_WAIT_V(8); PG8_WAIT_L(0); PG8_BAR; PG8_MMA(0, 0, At, B0); PG8_MMA(0, 1, At, B1); PG8_BAR; PG8_SCHED;
        PG8_LDA(At, 0, 1); PG8_STAGEB(PG8_SB(0, 0), b2); PG8_STAGEB(PG8_SB(0, 1), b2 + hstep); PG8_STAGE(PG8_SA(0, 0), a2);
        PG8_WAIT_V(8); PG8_WAIT_L(0); PG8_BAR; PG8_MMA(1, 0, At, B0); PG8_MMA(1, 1, At, B1); PG8_BAR; PG8_SCHED;
        PG8_LDB(B0, 1, 0); PG8_LDB(B1, 1, 1); PG8_SCHED; PG8_LDA(At, 1, 0); PG8_STAGE(PG8_SA(0, 1), a2 + hstep);
        PG8_WAIT_V(8); PG8_WAIT_L(0); PG8_BAR; PG8_MMA(0, 0, At, B0); PG8_MMA(0, 1, At, B1); PG8_BAR; PG8_SCHED;
        PG8_LDA(At, 1, 1); PG8_STAGEB(PG8_SB(1, 0), b3); PG8_STAGEB(PG8_SB(1, 1), b3 + hstep); PG8_STAGE(PG8_SA(1, 0), a3);
        PG8_WAIT_V(8); PG8_WAIT_L(0); PG8_BAR; PG8_MMA(1, 0, At, B0); PG8_MMA(1, 1, At, B1); PG8_BAR; PG8_SCHED;
        } else {
        PG8_LDB(B0, 0, 0); PG8_SCHED; PG8_LDA(At, 0, 0); PG8_STAGE(PG8_SA(1, 1), a1 + hstep);
        PG8_WAIT_L(8); PG8_BAR; PG8_WAIT_L(0); PG8_MMA(0, 0, At, B0); PG8_BAR; PG8_SCHED;
        PG8_LDB(B1, 0, 1); PG8_STAGEB(PG8_SB(0, 0), b2);
        PG8_BAR; PG8_WAIT_L(0); PG8_MMA(0, 1, At, B1); PG8_BAR;
        PG8_LDA(At, 0, 1); PG8_STAGE(PG8_SA(0, 0), a2);
        PG8_BAR; PG8_WAIT_L(0); PG8_MMA(1, 0, At, B0); PG8_BAR; PG8_SCHED;
        PG8_STAGEB(PG8_SB(0, 1), b2 + hstep);
        PG8_WAIT_V(6); PG8_BAR; PG8_MMA(1, 1, At, B1); PG8_BAR;
        PG8_LDB(B0, 1, 0); PG8_SCHED; PG8_LDA(At, 1, 0); PG8_STAGE(PG8_SA(0, 1), a2 + hstep);
        PG8_WAIT_L(8); PG8_BAR; PG8_WAIT_L(0); PG8_MMA(0, 0, At, B0); PG8_BAR; PG8_SCHED;
        PG8_LDB(B1, 1, 1); PG8_STAGEB(PG8_SB(1, 0), b3);
        PG8_BAR; PG8_WAIT_L(0); PG8_MMA(0, 1, At, B1); PG8_BAR;
        PG8_LDA(At, 1, 1); PG8_STAGE(PG8_SA(1, 0), a3);
        PG8_BAR; PG8_WAIT_L(0); PG8_MMA(1, 0, At, B0); PG8_BAR; PG8_SCHED;
        PG8_STAGEB(PG8_SB(1, 1), b3 + hstep);
        PG8_WAIT_V(6); PG8_BAR; PG8_MMA(1, 1, At, B1); PG8_BAR;
        }
      }
      if (G_ALIGN) { if (wr == 0) PG8_BAR; }
#pragma unroll
      for (int ai = 0; ai < 2; ++ai)
#pragma unroll
        for (int bj = 0; bj < 2; ++bj)
#pragma unroll
          for (int m = 0; m < 4; ++m)
            epi(cur.brow + ai * HALF + wr * 64 + m * 16 + fr, cur.bcol + bj * HALF + wc * 32 + fq * 8, acc[ai][bj][m][0], acc[ai][bj][m][1], cur.piece);
      if (!has_next) break;
#pragma unroll
      for (int a = 0; a < 2; ++a)
#pragma unroll
        for (int b = 0; b < 2; ++b)
#pragma unroll
          for (int m = 0; m < 4; ++m)
#pragma unroll
            for (int n = 0; n < 2; ++n) acc[a][b][m][n] = (f32x4){0.f, 0.f, 0.f, 0.f};
      cur = nxt; cA = nA; cB = nB; ++ui;
      if (G_ALIGN) { if (wr == 1) PG8_BAR; }
    }
    PG8_WAIT_V(0);
    if (!G_ALIGN) { if (wr == 0) PG8_BAR; }
    PG8_BAR;
  }
  __syncthreads();
#undef PG8_SA
#undef PG8_SB
#undef PG8_STAGE
#undef PG8_STAGEB
#undef PG8_STAGE_
#undef PG8_LDA
#undef PG8_LDB
#undef PG8_MMA
#undef PG8_WAIT_V
#undef PG8_WAIT_L
#undef PG8_BAR
#undef PG8_SCHED
#undef PG8_APTR
#undef PG8_BPTR
}

__device__ void mods_phase(unsigned char* lds, const Params& p) {
  float* sl = (float*)lds;
  float* red = sl + 9 * 1024;
  const int tid = opaque_tid();
  const float* c = p.in[1];
  const float* cc = p.in[3];
  float* mod = (float*)(p.ws + OFF_MOD);
  for (int tile = blockIdx.x; tile < 384; tile += gridDim.x) {
    const int l = tile / 192, cb = (tile % 192) * 32;
    for (int i = tid; i < 9 * 1024; i += 512) {
      float v = (i < 8192) ? c[i] : cc[i - 8192];
      sl[i] = siluf(v);
    }
    __syncthreads();
    const int cl = tid & 31, ks = tid >> 5;
    const float* aw = p.in[4] + (size_t)l * 1024 * 6144 + cb + cl;
    float acc[9];
#pragma unroll
    for (int r = 0; r < 9; ++r) acc[r] = 0.f;
    for (int k0 = ks * 64; k0 < ks * 64 + 64; k0 += 16) {
      float av[16];
#pragma unroll
      for (int u = 0; u < 16; ++u) av[u] = aw[(size_t)(k0 + u) * 6144];
#pragma unroll
      for (int u = 0; u < 16; ++u)
#pragma unroll
        for (int r = 0; r < 9; ++r) acc[r] += sl[r * 1024 + k0 + u] * av[u];
    }
#pragma unroll
    for (int r = 0; r < 9; ++r) red[(ks * 9 + r) * 32 + cl] = acc[r];
    __syncthreads();
    if (tid < 288) {
      const int r = tid >> 5, c2 = tid & 31;
      float s = 0.f;
      for (int q = 0; q < 16; ++q) s += red[(q * 9 + r) * 32 + c2];
      mod[((size_t)l * 9 + r) * 6144 + cb + c2] = s + p.in[5][(size_t)l * 6144 + cb + c2];
    }
    __syncthreads();
  }
}

__device__ __forceinline__ void convert_item(const float* src, int ldn, int K, bf16_t* dst, int kt, int nt, int srccol0, int tid) {
  const int nn = tid & 63, kc = tid >> 6;
  const float* sp = src + (size_t)(kt * 64 + kc * 8) * ldn + srccol0 + nn;
  float f[8];
#pragma unroll
  for (int i = 0; i < 8; ++i) f[i] = sp[(size_t)i * ldn];
  *(uint4*)(dst + (size_t)(nt * 64 + nn) * K + kt * 64 + kc * 8) = pack8(f);
}
__device__ void convert_win_wout(unsigned char* lds, const Params& p, int l, int first, int stride) {
  bf16_t* wint = (bf16_t*)(p.ws + OFF_WIN);
  bf16_t* woutt = (bf16_t*)(p.ws + OFF_WOUT);
  const float* win = p.in[8] + (size_t)l * 1024 * 3344;
  const float* wout = p.in[25] + (size_t)l * 1024 * 1024;
  const int tid = opaque_tid();
  for (int tile = first; tile < 832 + 256; tile += stride) {
    if (tile < 832) {
      const int nt = tile >> 4, kt = tile & 15;
      const int n0 = nt * 64;
      convert_item(win, 3344, 1024, wint, kt, nt, n0 < 2816 ? n0 : n0 + 16, tid);
    } else {
      const int t2 = tile - 832;
      const int nt = t2 >> 4, kt = t2 & 15;
      convert_item(wout, 1024, 1024, woutt, kt, nt, nt * 64, tid);
    }
  }
}
__device__ void convert_w1_w2(unsigned char* lds, const Params& p, int l, int first, int stride, int tile_hi = 2048) {
  bf16_t* w1t = (bf16_t*)(p.ws + OFF_W1);
  bf16_t* w2t = (bf16_t*)(p.ws + OFF_W2);
  const float* w1 = p.in[26] + (size_t)l * 1024 * 4096;
  const float* w2 = p.in[27] + (size_t)l * 4096 * 1024;
  const int tid = opaque_tid();
  for (int tile = first; tile < tile_hi; tile += stride) {
    if (tile < 1024) {
      const int nt = tile >> 4, kt = tile & 15;
      convert_item(w1, 4096, 1024, w1t, kt, nt, nt * 64, tid);
    } else {
      const int t2 = tile - 1024;
      const int nt = t2 >> 6, kt = t2 & 63;
      convert_item(w2, 1024, 4096, w2t, kt, nt, nt * 64, tid);
    }
  }
}

__device__ void rgw_phase(const Params& p) {
  bf16_t* rgw = (bf16_t*)(p.ws + OFF_RGW);
  const int tid = opaque_tid();
  for (int idx = blockIdx.x * 512 + tid; idx < 2 * 16 * 4096; idx += gridDim.x * 512) {
    const int i = idx & 63, j = (idx >> 6) & 63, mat = idx >> 12;
    rgw[idx] = f2bf(p.in[21][(size_t)mat * 4096 + i * 64 + j]);
  }
}

__device__ void filters_phase(unsigned char* lds, const Params& p) {
  float* feats = (float*)lds;
  float* h1 = feats + 8 * 33;
  float* h2 = h1 + 8 * 64;
  const int tid = opaque_tid();
  float* filt = (float*)(p.ws + OFF_FILT);
  for (int tile = blockIdx.x; tile < 576; tile += gridDim.x) {
    const int l = tile / 288, pt = tile % 288;
    const int posidx0 = pt * 8;
    const int L = (posidx0 < 2048) ? 2048 : 256;
    const int pos0 = (posidx0 < 2048) ? posidx0 : posidx0 - 2048;
    const float* w1 = p.in[10] + l * 33 * 64;
    const float* b1 = p.in[11] + l * 64;
    const float* w2 = p.in[12] + l * 64 * 64;
    const float* b2 = p.in[13] + l * 64;
    const float* w3 = p.in[14] + l * 64 * 512;
    const float* b3 = p.in[15] + l * 512;
    const float* fq = p.in[16] + l * 128;
    if (tid < 8 * 33) {
      const int pp = tid / 33, f = tid % 33;
      const float pos = (float)(pos0 + pp);
      float v;
      if (f == 0) v = pos / (float)(L - 1);
      else {
        const int bi = (f - 1) & 15;
        const float fr = 1e-4f + (float)bi * ((15.0f - 1e-4f) / 15.0f);
        const float kk = (float)(2.0 * 3.14159265358979323846 / (double)L);
        const float ang = (kk * fr) * pos;
        v = (f <= 16) ? cosf(ang) : -sinf(ang);
      }
      feats[pp * 33 + f] = v;
    }
    __syncthreads();
    {
      const int pp = tid >> 6, j = tid & 63;
      float s = b1[j];
      for (int f = 0; f < 33; ++f) s += feats[pp * 33 + f] * w1[f * 64 + j];
      h1[pp * 64 + j] = sinf(fq[j] * s);
    }
    __syncthreads();
    {
      const int pp = tid >> 6, j = tid & 63;
      float s = b2[j];
      for (int i = 0; i < 64; ++i) s += h1[pp * 64 + i] * w2[i * 64 + j];
      h2[pp * 64 + j] = sinf(fq[64 + j] * s);
    }
    __syncthreads();
    {
      const int col = tid;
      const int dir = col >> 8, c = col & 255;
      float acc[8];
#pragma unroll
      for (int pp = 0; pp < 8; ++pp) acc[pp] = b3[col];
      for (int i = 0; i < 64; ++i) {
        const float wv = w3[i * 512 + col];
#pragma unroll
        for (int pp = 0; pp < 8; ++pp) acc[pp] += h2[pp * 64 + i] * wv;
      }
      const float mind = -3.0701134573253944f, maxd = -15.350567286626973f;
      const float delta = fabsf(mind + (float)c * ((maxd - mind) / 255.0f));
      float* dst = filt + ((size_t)(l * 256 + c) * 2 + dir) * LTOT + posidx0;
#pragma unroll
      for (int pp = 0; pp < 8; ++pp) {
        const float t = (float)(pos0 + pp) / (float)(L - 1);
        dst[pp] = acc[pp] * expf(-t * delta);
      }
    }
    __syncthreads();
  }
}

template <int NR, bool GATES>
__device__ void norm_phase(unsigned char* lds, const Params& p, int l, const float* xlat, const float* xctx, const float* cadd, const float* gamma, int shift_i, int nrows) {
  const int tid = opaque_tid(), lane = tid & 63, w = tid >> 6;
  const float* mod = (const float*)(p.ws + OFF_MOD) + (size_t)l * 9 * 6144;
  bf16_t* act = (bf16_t*)(p.ws + OFF_ACT);
  float* G = (float*)(p.ws + OFF_G);
  const float* gb = p.in[19] + l * 16;
  float* wT = (float*)lds;
  if (GATES) {
    const float* wg = p.in[8] + (size_t)l * 1024 * 3344 + 2816;
#pragma unroll
    for (int kk = 0; kk < 2; ++kk) {
      const int k = tid + 512 * kk;
      const float4 a0 = *(const float4*)(wg + (size_t)k * 3344);
      const float4 a1 = *(const float4*)(wg + (size_t)k * 3344 + 4);
      const float4 a2 = *(const float4*)(wg + (size_t)k * 3344 + 8);
      const float4 a3 = *(const float4*)(wg + (size_t)k * 3344 + 12);
      wT[0 * 1024 + k] = a0.x; wT[1 * 1024 + k] = a0.y; wT[2 * 1024 + k] = a0.z; wT[3 * 1024 + k] = a0.w;
      wT[4 * 1024 + k] = a1.x; wT[5 * 1024 + k] = a1.y; wT[6 * 1024 + k] = a1.z; wT[7 * 1024 + k] = a1.w;
      wT[8 * 1024 + k] = a2.x; wT[9 * 1024 + k] = a2.y; wT[10 * 1024 + k] = a2.z; wT[11 * 1024 + k] = a2.w;
      wT[12 * 1024 + k] = a3.x; wT[13 * 1024 + k] = a3.y; wT[14 * 1024 + k] = a3.z; wT[15 * 1024 + k] = a3.w;
    }
    __syncthreads();
  }
  for (int r00 = (blockIdx.x * 8 + w) * NR; r00 < REP_NORM * nrows; r00 += gridDim.x * 8 * NR) {
    const int r0 = (REP_NORM > 1) ? r00 % nrows : r00;
    const float* mr[NR];
    const float* src[NR];
    float rstd[NR];
#pragma unroll
    for (int q = 0; q < NR; ++q) {
      const int r = r0 + q;
      if (r < NLAT) { src[q] = xlat + (size_t)r * 1024; mr[q] = mod + (size_t)(r >> 11) * 6144; }
      else { src[q] = xctx + (size_t)(r - NLAT) * 1024; mr[q] = mod + (size_t)8 * 6144; }
    }
    float ga[NR][16];
#pragma unroll
    for (int q = 0; q < NR; ++q)
#pragma unroll
      for (int g = 0; g < 16; ++g) ga[q][g] = 0.f;
    if (!GATES) {
      float4 v[NR][4];
#pragma unroll
      for (int q = 0; q < NR; ++q)
#pragma unroll
        for (int i = 0; i < 4; ++i) v[q][i] = *(const float4*)(src[q] + i * 256 + lane * 4);
#pragma unroll
      for (int q = 0; q < NR; ++q) {
        float ss = 0.f;
#pragma unroll
        for (int i = 0; i < 4; ++i) ss += v[q][i].x * v[q][i].x + v[q][i].y * v[q][i].y + v[q][i].z * v[q][i].z + v[q][i].w * v[q][i].w;
        ss = wsum(ss, lane);
        rstd[q] = rsqrtf(ss * (1.f / 1024.f) + EPSF);
      }
#pragma unroll
      for (int i = 0; i < 4; ++i) {
        const int k = i * 256 + lane * 4;
        const float4 g4 = *(const float4*)(gamma + k);
#pragma unroll
        for (int q = 0; q < NR; ++q) {
          const float4 sh = *(const float4*)(mr[q] + shift_i * 1024 + k);
          const float4 sc = *(const float4*)(mr[q] + (shift_i + 1) * 1024 + k);
          const float o0 = (v[q][i].x * rstd[q] * g4.x) * (1.f + sc.x) + sh.x;
          const float o1 = (v[q][i].y * rstd[q] * g4.y) * (1.f + sc.y) + sh.y;
          const float o2 = (v[q][i].z * rstd[q] * g4.z) * (1.f + sc.z) + sh.z;
          const float o3 = (v[q][i].w * rstd[q] * g4.w) * (1.f + sc.w) + sh.w;
          uint2 pk; pk.x = pack2(o0, o1); pk.y = pack2(o2, o3);
          *(uint2*)(act + (size_t)(r0 + q) * 1024 + k) = pk;
        }
      }
    } else {
#pragma unroll
      for (int q = 0; q < NR; ++q) {
        float ss = 0.f;
#pragma unroll
        for (int i = 0; i < 4; ++i) {
          float4 t4 = *(const float4*)(src[q] + i * 256 + lane * 4);
          if (cadd != nullptr && r0 + q >= NLAT) {
            const float4 a1 = *(const float4*)(cadd + (size_t)(r0 + q - NLAT) * 1024 + i * 256 + lane * 4);
            const float4 a2 = *(const float4*)(cadd + (size_t)2048 * 1024 + (size_t)(r0 + q - NLAT) * 1024 + i * 256 + lane * 4);
            t4.x += a1.x + a2.x; t4.y += a1.y + a2.y; t4.z += a1.z + a2.z; t4.w += a1.w + a2.w;
          }
          ss += t4.x * t4.x + t4.y * t4.y + t4.z * t4.z + t4.w * t4.w;
        }
        ss = wsum(ss, lane);
        rstd[q] = rsqrtf(ss * (1.f / 1024.f) + EPSF);
      }
#pragma unroll 1
      for (int i = 0; i < 4; ++i) {
        const int k = i * 256 + lane * 4;
        const float4 g4 = *(const float4*)(gamma + k);
        float o[NR][4];
#pragma unroll
        for (int q = 0; q < NR; ++q) {
          float4 vv = *(const float4*)(src[q] + k);
          if (cadd != nullptr && r0 + q >= NLAT) {
            const float4 a1 = *(const float4*)(cadd + (size_t)(r0 + q - NLAT) * 1024 + k);
            const float4 a2 = *(const float4*)(cadd + (size_t)2048 * 1024 + (size_t)(r0 + q - NLAT) * 1024 + k);
            vv.x += a1.x + a2.x; vv.y += a1.y + a2.y; vv.z += a1.z + a2.z; vv.w += a1.w + a2.w;
          }
          const float4 sh = *(const float4*)(mr[q] + shift_i * 1024 + k);
          const float4 sc = *(const float4*)(mr[q] + (shift_i + 1) * 1024 + k);
          o[q][0] = (vv.x * rstd[q] * g4.x) * (1.f + sc.x) + sh.x;
          o[q][1] = (vv.y * rstd[q] * g4.y) * (1.f + sc.y) + sh.y;
          o[q][2] = (vv.z * rstd[q] * g4.z) * (1.f + sc.z) + sh.z;
          o[q][3] = (vv.w * rstd[q] * g4.w) * (1.f + sc.w) + sh.w;
          uint2 pk; pk.x = pack2(o[q][0], o[q][1]); pk.y = pack2(o[q][2], o[q][3]);
          *(uint2*)(act + (size_t)(r0 + q) * 1024 + k) = pk;
        }
#pragma unroll
        for (int g = 0; g < 16; ++g) {
          const float4 w4 = *(const float4*)(wT + g * 1024 + k);
#pragma unroll
          for (int q = 0; q < NR; ++q) ga[q][g] += o[q][0] * w4.x + o[q][1] * w4.y + o[q][2] * w4.z + o[q][3] * w4.w;
        }
      }
    }
    if (GATES) {
#pragma unroll
      for (int q = 0; q < NR; ++q) {
        float r8[8], r4[4], r2[2];
        const bool b5 = (lane & 32) != 0, b4 = (lane & 16) != 0, b3 = (lane & 8) != 0, b2 = (lane & 4) != 0;
#pragma unroll
        for (int j = 0; j < 8; ++j) {
          const float mine = b5 ? ga[q][j + 8] : ga[q][j];
          const float send = b5 ? ga[q][j] : ga[q][j + 8];
          r8[j] = mine + shfl_idx(send, lane ^ 32);
        }
#pragma unroll
        for (int j = 0; j < 4; ++j) {
          const float mine = b4 ? r8[j + 4] : r8[j];
          const float send = b4 ? r8[j] : r8[j + 4];
          r4[j] = mine + shfl_idx(send, lane ^ 16);
        }
#pragma unroll
        for (int j = 0; j < 2; ++j) {
          const float mine = b3 ? r4[j + 2] : r4[j];
          const float send = b3 ? r4[j] : r4[j + 2];
          r2[j] = mine + shfl_idx(send, lane ^ 8);
        }
        float tot;
        {
          const float mine = b2 ? r2[1] : r2[0];
          const float send = b2 ? r2[0] : r2[1];
          tot = mine + shfl_idx(send, lane ^ 4);
        }
        tot += shfl_idx(tot, lane ^ 2);
        tot += shfl_idx(tot, lane ^ 1);
        const int gidx = ((lane >> 2) & 1) | (((lane >> 3) & 1) << 1) | (((lane >> 4) & 1) << 2) | (((lane >> 5) & 1) << 3);
        if ((lane & 3) == 0) G[(size_t)(r0 + q) * 16 + gidx] = tot + gb[gidx];
      }
    }
  }
  if (GATES) __syncthreads();
}

__device__ void final_norm_phase(const Params& p) {
  const int tid = opaque_tid(), lane = tid & 63, w = tid >> 6;
  const float* gamma = p.in[28];
  for (int r0 = (blockIdx.x * 8 + w) * 4; r0 < NLAT; r0 += gridDim.x * 8 * 4) {
    float4 v[4][4];
    float rstd[4];
#pragma unroll
    for (int q = 0; q < 4; ++q) {
      const float* src = p.out + (size_t)(r0 + q) * 1024;
      float ss = 0.f;
#pragma unroll
      for (int i = 0; i < 4; ++i) {
        v[q][i] = *(const float4*)(src + i * 256 + lane * 4);
        ss += v[q][i].x * v[q][i].x + v[q][i].y * v[q][i].y + v[q][i].z * v[q][i].z + v[q][i].w * v[q][i].w;
      }
      ss = wsum(ss, lane);
      rstd[q] = rsqrtf(ss * (1.f / 1024.f) + EPSF);
    }
#pragma unroll
    for (int i = 0; i < 4; ++i) {
      const int k = i * 256 + lane * 4;
      const float4 g4 = *(const float4*)(gamma + k);
#pragma unroll
      for (int q = 0; q < 4; ++q) {
        float4 o;
        o.x = v[q][i].x * rstd[q] * g4.x; o.y = v[q][i].y * rstd[q] * g4.y; o.z = v[q][i].z * rstd[q] * g4.z; o.w = v[q][i].w * rstd[q] * g4.w;
        *(float4*)(p.out + (size_t)(r0 + q) * 1024 + k) = o;
      }
    }
  }
}

__device__ __forceinline__ int ml_row_pos(int b, bool isctx, int pos) {
  return isctx ? (NLAT + b * 256 + pos) : (b * 2048 + (pos & 31) * 64 + (pos >> 5));
}
__device__ __forceinline__ int sidx(int dir, int b, int h, int n) { return ((dir * 8 + b) * 4 + h) * 18 + n; }

__device__ __forceinline__ void ml_conv8_load(const bf16_t* z, int zcol, int b, bool isctx, int L, int pos, uint4* u) {
#pragma unroll
  for (int j = 0; j < 4; ++j) {
    const int pp = pos + j - 1;
    const int pc = pp < 0 ? 0 : (pp >= L ? L - 1 : pp);
    u[j] = *(const uint4*)(z + (size_t)ml_row_pos(b, isctx, pc) * ZS + zcol);
  }
}
__device__ __forceinline__ void ml_conv8_comp(const uint4* u, const float* wc, int ccol, int L, int pos, float* o) {
#pragma unroll
  for (int e = 0; e < 8; ++e) o[e] = 0.f;
#pragma unroll
  for (int j = 0; j < 4; ++j) {
    const int pp = pos + j - 1;
    const float mk = (pp >= 0 && pp < L) ? 1.f : 0.f;
    float f[8];
    unpack8(u[j], f);
    const float4 w0 = *(const float4*)(wc + j * 1024 + ccol);
    const float4 w1 = *(const float4*)(wc + j * 1024 + ccol + 4);
    o[0] += f[0] * (w0.x * mk); o[1] += f[1] * (w0.y * mk); o[2] += f[2] * (w0.z * mk); o[3] += f[3] * (w0.w * mk);
    o[4] += f[4] * (w1.x * mk); o[5] += f[5] * (w1.y * mk); o[6] += f[6] * (w1.z * mk); o[7] += f[7] * (w1.w * mk);
  }
#pragma unroll
  for (int e = 0; e < 8; ++e) o[e] = siluf(o[e]);
}
__device__ __forceinline__ void ml_conv8(const bf16_t* z, const float* wc, int zcol, int ccol, int b, bool isctx, int L, int pos, float* o) {
  uint4 u[4];
  ml_conv8_load(z, zcol, b, isctx, L, pos, u);
  ml_conv8_comp(u, wc, ccol, L, pos, o);
}

__device__ __forceinline__ void ml_prep_load(const float* G, int b, int n, int h, int tid, float* g4) {
  const bool isctx = n < 2;
  const int p0 = isctx ? n * 128 : (n - 2) * 128;
  const float* g = G + (size_t)ml_row_pos(b, isctx, p0 + (tid & 127)) * 16;
  g4[0] = g[0 + h]; g4[1] = g[4 + h]; g4[2] = g[8 + h]; g4[3] = g[12 + h];
}
__device__ __forceinline__ void ml_prep(float* vec, const float* g4, float* scal, int b, int n, int h, bool outmode) {
  const int tid = opaque_tid();
  if (tid < 128) {
    vec[0 * 128 + tid] = g4[0];
    vec[1 * 128 + tid] = logsig(g4[1]);
    vec[2 * 128 + tid] = g4[2];
    vec[3 * 128 + tid] = logsig(g4[3]);
  }
  __syncthreads();
  if (tid < 128) {
    const int dir = tid >> 6, lane = tid & 63;
    const float* LI = vec + (dir * 2) * 128;
    const float* LF = vec + (dir * 2 + 1) * 128;
    const int i0 = dir ? 127 - 2 * lane : 2 * lane;
    const int i1 = dir ? i0 - 1 : i0 + 1;
    const float x0 = LF[i0], x1 = LF[i1];
    const float s2 = x0 + x1;
    float inc = s2;
#pragma unroll
    for (int o = 1; o < 64; o <<= 1) { const float t = shfl_idx(inc, lane - o); if (lane >= o) inc += t; }
    const float b0 = inc - s2 + x0, b1 = inc;
    const float btot = shfl_idx(inc, 63);
    const float li0 = LI[i0], li1 = LI[i1];
    const int sid = sidx(dir, b, h, n);
    if (!outmode) {
      const float g0 = btot - b0 + li0, g1 = btot - b1 + li1;
      float mx = fmaxf(g0, g1);
#pragma unroll
      for (int o = 32; o > 0; o >>= 1) mx = fmaxf(mx, shfl_idx(mx, lane ^ o));
      vec[(6 + dir) * 128 + i0] = fexp(g0 - mx);
      vec[(6 + dir) * 128 + i1] = fexp(g1 - mx);
      if (lane == 0) { scal[sid] = btot; scal[1152 + sid] = mx; }
    } else {
      const float m0 = scal[2304 + sid];
      const float c0 = li0 - b0, c1 = li1 - b1;
      float rmx = fmaxf(c0, c1);
#pragma unroll
      for (int o = 1; o < 64; o <<= 1) { const float t = shfl_idx(rmx, lane - o); if (lane >= o) rmx = fmaxf(rmx, t); }
      float prev = shfl_idx(rmx, lane - 1);
      if (lane == 0) prev = -INFINITY;
      const float r0 = fmaxf(prev, c0), r1 = rmx;
      float* base = vec + (6 + 4 * dir) * 128;
      {
        const float inter = b0 + m0, mt = fmaxf(inter, b0 + r0);
        base[i0] = b0 - mt; base[128 + i0] = c0; base[256 + i0] = fexp(inter - mt); base[384 + i0] = fexp(-mt);
      }
      {
        const float inter = b1 + m0, mt = fmaxf(inter, b1 + r1);
        base[i1] = b1 - mt; base[128 + i1] = c1; base[256 + i1] = fexp(inter - mt); base[384 + i1] = fexp(-mt);
      }
    }
  }
  __syncthreads();
}

__device__ void ml_local_tile(unsigned char* lds, const Params& p, int l, int b, int h, int n) {
  bf16_t* KT = (bf16_t*)lds;
  bf16_t* VF = KT + 128 * 136;
  bf16_t* VB = VF + 128 * 136;
  float* vec = (float*)(VB + 128 * 136);
  const int tid = opaque_tid(), lane = tid & 63, w = tid >> 6, lr = lane & 15, lg = lane >> 4;
  const bf16_t* z = (const bf16_t*)(p.ws + OFF_A);
  const float* G = (const float*)(p.ws + OFF_G);
  bf16_t* Cst = (bf16_t*)(p.ws + OFF_ST);
  float* nst = (float*)(p.ws + OFF_NST);
  float* scal = (float*)(p.ws + OFF_SCAL);
  const bool isctx = n < 2;
  const int L = isctx ? 256 : 2048;
  const int p0 = isctx ? n * 128 : (n - 2) * 128;
  float g4[4];
  ml_prep_load(G, b, n, h, tid, g4);
  uint4 ku[4][4], vu[4];
  {
    const int s = tid & 127, ec0 = tid >> 7;
    const int row = ml_row_pos(b, isctx, p0 + s);
#pragma unroll
    for (int i = 0; i < 4; ++i) {
      const int ec = ec0 + 4 * i;
      ml_conv8_load(z, 768 + 512 + h * 128 + ec * 8, b, isctx, L, p0 + s, ku[i]);
      vu[i] = *(const uint4*)(z + (size_t)row * ZS + 768 + 1024 + h * 128 + ec * 8);
    }
  }
  ml_prep(vec, g4, scal, b, n, h, false);
  {
    const int s = tid & 127, ec0 = tid >> 7;
    const float wf = vec[6 * 128 + s], wb = vec[7 * 128 + s];
    const float* wc = p.in[18] + (size_t)l * 4 * 1024;
#pragma unroll
    for (int i = 0; i < 4; ++i) {
      const int ec = ec0 + 4 * i;
      float k8[8];
      ml_conv8_comp(ku[i], wc, 512 + h * 128 + ec * 8, L, p0 + s, k8);
      float v8[8];
      unpack8(vu[i], v8);
#pragma unroll
      for (int e = 0; e < 8; ++e) {
        KT[(ec * 8 + e) * 136 + s] = f2bf(k8[e] * 0.08838834764831845f);
        VF[(ec * 8 + e) * 136 + s] = f2bf(v8[e] * wf);
        VB[(ec * 8 + e) * 136 + s] = f2bf(v8[e] * wb);
      }
    }
  }
  __syncthreads();
  {
    f32x4 accf[8], accb[8];
#pragma unroll
    for (int i = 0; i < 8; ++i) { accf[i] = (f32x4){0.f, 0.f, 0.f, 0.f}; accb[i] = (f32x4){0.f, 0.f, 0.f, 0.f}; }
#pragma unroll
    for (int ks = 0; ks < 4; ++ks) {
      const bf16x8 bfv = ldfrag(VF + (16 * w + lr) * 136 + ks * 32 + lg * 8);
      const bf16x8 bbv = ldfrag(VB + (16 * w + lr) * 136 + ks * 32 + lg * 8);
#pragma unroll
      for (int ef = 0; ef < 8; ++ef) {
        const bf16x8 a = ldfrag(KT + (ef * 16 + lr) * 136 + ks * 32 + lg * 8);
        accf[ef] = mfma16(a, bfv, accf[ef]);
        accb[ef] = mfma16(a, bbv, accb[ef]);
      }
    }
    bf16_t* cf = Cst + (size_t)sidx(0, b, h, n) * 16384 + (16 * w + lr) * 128;
    bf16_t* cb = Cst + (size_t)sidx(1, b, h, n) * 16384 + (16 * w + lr) * 128;
#pragma unroll
    for (int ef = 0; ef < 8; ++ef) {
      uint2 u; u.x = pack2(accf[ef][0], accf[ef][1]); u.y = pack2(accf[ef][2], accf[ef][3]);
      *(uint2*)(cf + ef * 16 + lg * 4) = u;
      uint2 u2; u2.x = pack2(accb[ef][0], accb[ef][1]); u2.y = pack2(accb[ef][2], accb[ef][3]);
      *(uint2*)(cb + ef * 16 + lg * 4) = u2;
    }
  }
  if (tid < 256) {
    const int e = tid & 127, dir = tid >> 7;
    const float* wv = vec + (6 + dir) * 128;
    float s = 0.f;
    for (int q = 0; q < 128; ++q) s += wv[q] * bf2f(KT[e * 136 + q]);
    nst[(size_t)sidx(dir, b, h, n) * 128 + e] = s;
  }
  __syncthreads();
}

__device__ void ml_scan_phase(const Params& p) {
  const int tid = opaque_tid();
  bf16_t* Cst = (bf16_t*)(p.ws + OFF_ST);
  float* nst = (float*)(p.ws + OFF_NST);
  float* scal = (float*)(p.ws + OFF_SCAL);
  for (int tile = blockIdx.x; tile < 512; tile += gridDim.x) {
    const int slice = tile & 7, seq = tile >> 3;
    const int h = seq & 3, b = (seq >> 2) & 7, dir = seq >> 5;
    const bool don = (slice == 0 && tid < 128);
    uint2 u[18];
    float nl[18], bl[18], ml[18];
#pragma unroll
    for (int i = 0; i < 18; ++i) {
      const int n = (dir == 0) ? i : (i < 2 ? 1 - i : 19 - i);
      const int sid = sidx(dir, b, h, n);
      u[i] = *(const uint2*)(Cst + (size_t)sid * 16384 + slice * 2048 + tid * 4);
      nl[i] = don ? nst[(size_t)sid * 128 + tid] : 0.f;
      bl[i] = scal[sid];
      ml[i] = scal[1152 + sid];
    }
    float m = 0.f;
    float zz = 0.f;
    asm volatile("" : "+v"(zz));
    float cr[4] = {zz, zz, zz, zz};
    float nr = zz;
#pragma unroll
    for (int i = 0; i < 18; ++i) {
      const int n = (dir == 0) ? i : (i < 2 ? 1 - i : 19 - i);
      const int sid = sidx(dir, b, h, n);
      const float mnew = fmaxf(bl[i] + m, ml[i]);
      const float a = fexp(bl[i] + m - mnew), sc = fexp(ml[i] - mnew);
      uint2 o; o.x = pack2(cr[0], cr[1]); o.y = pack2(cr[2], cr[3]);
      *(uint2*)(Cst + (size_t)sid * 16384 + slice * 2048 + tid * 4) = o;
      cr[0] = a * cr[0] + sc * lo16(u[i].x); cr[1] = a * cr[1] + sc * hi16(u[i].x);
      cr[2] = a * cr[2] + sc * lo16(u[i].y); cr[3] = a * cr[3] + sc * hi16(u[i].y);
      if (don) {
        nst[(size_t)sid * 128 + tid] = nr;
        nr = a * nr + sc * nl[i];
      }
      if (slice == 0 && tid == 0) scal[2304 + sid] = m;
      m = mnew;
    }
  }
}

__device__ void ml_out_tile(unsigned char* lds, const Params& p, int l, int b, int h, int n) {
  bf16_t* C0s = (bf16_t*)lds;
  bf16_t* Ks = C0s + 128 * 136;
  bf16_t* VT = Ks + 128 * 136;
  bf16_t* Ps = VT + 128 * 136;
  float* vec = (float*)(Ps + 128 * 136);
  const int tid = opaque_tid(), lane = tid & 63, w = tid >> 6, lr = lane & 15, lg = lane >> 4;
  const bf16_t* z = (const bf16_t*)(p.ws + OFF_A);
  const float* G = (const float*)(p.ws + OFF_G);
  const bf16_t* Cst = (const bf16_t*)(p.ws + OFF_ST);
  const float* nst = (const float*)(p.ws + OFF_NST);
  const float* scal = (const float*)(p.ws + OFF_SCAL);
  bf16_t* y = (bf16_t*)(p.ws + OFF_ACT);
  const bool isctx = n < 2;
  const int L = isctx ? 256 : 2048;
  const int p0 = isctx ? n * 128 : (n - 2) * 128;
  const int t = 16 * w + lr;
  float g4[4];
  ml_prep_load(G, b, n, h, tid, g4);
  if (tid >= 128 && tid < 384) {
    const int q = tid - 128, dir = q >> 7, e = q & 127;
    vec[(14 + dir) * 128 + e] = nst[(size_t)sidx(dir, b, h, n) * 128 + e];
  }
  const int orow = ml_row_pos(b, isctx, p0 + t);
  uint2 ou[8];
#pragma unroll
  for (int df = 0; df < 8; ++df) ou[df] = make_uint2(0u, 0u);
  const float* wc = p.in[18] + (size_t)l * 4 * 1024;
  {
    const int s = tid & 127, ec0 = tid >> 7;
    const int row = ml_row_pos(b, isctx, p0 + s);
#pragma unroll 2
    for (int i = 0; i < 4; ++i) {
      const int ec = ec0 + 4 * i;
      float k8[8], v8[8];
      ml_conv8(z, wc, 768 + 512 + h * 128 + ec * 8, 512 + h * 128 + ec * 8, b, isctx, L, p0 + s, k8);
#pragma unroll
      for (int e = 0; e < 8; ++e) k8[e] *= 0.08838834764831845f;
      *(uint4*)(Ks + s * 136 + ec * 8) = pack8(k8);
      const uint4 vu = *(const uint4*)(z + (size_t)row * ZS + 768 + 1024 + h * 128 + ec * 8);
      unpack8(vu, v8);
#pragma unroll
      for (int e = 0; e < 8; ++e) VT[(ec * 8 + e) * 136 + s] = f2bf(v8[e]);
    }
  }
  uint4 c0f[4];
  {
    const bf16_t* Cf = Cst + (size_t)sidx(0, b, h, n) * 16384;
#pragma unroll
    for (int i = 0; i < 4; ++i) {
      const int id = tid + 512 * i;
      c0f[i] = *(const uint4*)(Cf + (id >> 4) * 128 + (id & 15) * 8);
    }
  }
  bf16x8 qf[4];
#pragma unroll
  for (int ks = 0; ks < 4; ++ks) {
    const int ec = ks * 4 + lg;
    float q8[8];
    ml_conv8(z, wc, 768 + h * 128 + ec * 8, h * 128 + ec * 8, b, isctx, L, p0 + t, q8);
    const uint4 pk = pack8(q8);
    qf[ks] = __builtin_bit_cast(bf16x8, pk);
  }
#pragma unroll
  for (int i = 0; i < 4; ++i) {
    const int id = tid + 512 * i;
    *(uint4*)(C0s + (id >> 4) * 136 + (id & 15) * 8) = c0f[i];
  }
  ml_prep(vec, g4, const_cast<float*>(scal), b, n, h, true);
  {
    float qnf = 0.f, qnb = 0.f;
#pragma unroll
    for (int ks = 0; ks < 4; ++ks) {
      float qv[8];
      unpack8(__builtin_bit_cast(uint4, qf[ks]), qv);
#pragma unroll
      for (int e = 0; e < 8; ++e) {
        qnf += qv[e] * vec[14 * 128 + (ks * 4 + lg) * 8 + e];
        qnb += qv[e] * vec[15 * 128 + (ks * 4 + lg) * 8 + e];
      }
    }
    qnf += shfl_idx(qnf, lane ^ 16); qnf += shfl_idx(qnf, lane ^ 32);
    qnb += shfl_idx(qnb, lane ^ 16); qnb += shfl_idx(qnb, lane ^ 32);
    if (lg == 0) { vec[17 * 128 + t] = qnf; vec[18 * 128 + t] = qnb; }
  }
  f32x4 hsum[8];
#pragma unroll
  for (int i = 0; i < 8; ++i) hsum[i] = (f32x4){0.f, 0.f, 0.f, 0.f};
#pragma unroll 1
  for (int dir = 0; dir < 2; ++dir) {
    uint4 cn[4];
    if (dir == 0) {
      const bf16_t* Cb = Cst + (size_t)sidx(1, b, h, n) * 16384;
#pragma unroll
      for (int i = 0; i < 4; ++i) {
        const int id = tid + 512 * i;
        cn[i] = *(const uint4*)(Cb + (id >> 4) * 128 + (id & 15) * 8);
      }
    } else {
#pragma unroll
      for (int i = 0; i < 4; ++i) cn[i] = make_uint4(0u, 0u, 0u, 0u);
#pragma unroll
      for (int df = 0; df < 8; ++df) ou[df] = *(const uint2*)(z + (size_t)orow * ZS + 768 + 1536 + h * 128 + df * 16 + lg * 4);
    }
    const float* ROWV = vec + (6 + 4 * dir) * 128;
    const float* COLV = vec + (7 + 4 * dir) * 128;
    const float* WI = vec + (8 + 4 * dir) * 128;
    const float* EM = vec + (9 + 4 * dir) * 128;
    const float* QN = vec + (17 + dir) * 128;
    float* DINV = vec + 16 * 128;
    {
      const float rv = ROWV[t];
#pragma unroll
      for (int sf = 0; sf < 8; ++sf) {
        f32x4 acc = (f32x4){0.f, 0.f, 0.f, 0.f};
#pragma unroll
        for (int ks = 0; ks < 4; ++ks) {
          const bf16x8 kf = ldfrag(Ks + (sf * 16 + lr) * 136 + ks * 32 + lg * 8);
          acc = mfma16(kf, qf[ks], acc);
        }
        float pv[4];
#pragma unroll
        for (int j = 0; j < 4; ++j) {
          const int s = sf * 16 + lg * 4 + j;
          const bool ok = (dir == 0) ? (s <= t) : (s >= t);
          pv[j] = ok ? acc[j] * fexp(rv + COLV[s]) : 0.f;
        }
        uint2 u; u.x = pack2(pv[0], pv[1]); u.y = pack2(pv[2], pv[3]);
        *(uint2*)(Ps + t * 136 + sf * 16 + lg * 4) = u;
      }
    }
    __syncthreads();
    if (tid < 128) {
      float rs = 0.f;
#pragma unroll
      for (int c8 = 0; c8 < 16; ++c8) {
        float f[8];
        unpack8(*(const uint4*)(Ps + tid * 136 + c8 * 8), f);
#pragma unroll
        for (int e = 0; e < 8; ++e) rs += f[e];
      }
      const float den = rs + WI[tid] * QN[tid];
      DINV[tid] = frcp(fmaxf(fabsf(den), EM[tid]));
    }
    __syncthreads();
    {
      bf16x8 pf[4];
#pragma unroll
      for (int ks = 0; ks < 4; ++ks) pf[ks] = ldfrag(Ps + t * 136 + ks * 32 + lg * 8);
      const float wi = WI[t];
      const float di = DINV[t];
#pragma unroll
      for (int df = 0; df < 8; ++df) {
        f32x4 a1 = (f32x4){0.f, 0.f, 0.f, 0.f}, a2 = (f32x4){0.f, 0.f, 0.f, 0.f};
#pragma unroll
        for (int ks = 0; ks < 4; ++ks) {
          const bf16x8 vf = ldfrag(VT + (df * 16 + lr) * 136 + ks * 32 + lg * 8);
          a1 = mfma16(vf, pf[ks], a1);
          const bf16x8 cf = ldfrag(C0s + (df * 16 + lr) * 136 + ks * 32 + lg * 8);
          a2 = mfma16(cf, qf[ks], a2);
        }
#pragma unroll
        for (int j = 0; j < 4; ++j) hsum[df][j] += (a1[j] + wi * a2[j]) * di;
      }
    }
    __syncthreads();
    if (dir == 0) {
#pragma unroll
      for (int i = 0; i < 4; ++i) {
        const int id = tid + 512 * i;
        *(uint4*)(C0s + (id >> 4) * 136 + (id & 15) * 8) = cn[i];
      }
    }
  }
  {
    float ss = 0.f;
#pragma unroll
    for (int df = 0; df < 8; ++df)
#pragma unroll
      for (int j = 0; j < 4; ++j) ss += hsum[df][j] * hsum[df][j];
    ss += shfl_idx(ss, lane ^ 16);
    ss += shfl_idx(ss, lane ^ 32);
    const float rn = rsqrtf(ss * (1.f / 128.f) + EPSF);
    const float* gm = p.in[24] + (size_t)l * 1024 + 256 + h * 128;
#pragma unroll
    for (int df = 0; df < 8; ++df) {
      const int d = df * 16 + lg * 4;
      const float4 gg = *(const float4*)(gm + d);
      float o0 = hsum[df][0] * rn * gg.x * sigm(lo16(ou[df].x));
      float o1 = hsum[df][1] * rn * gg.y * sigm(hi16(ou[df].x));
      float o2 = hsum[df][2] * rn * gg.z * sigm(lo16(ou[df].y));
      float o3 = hsum[df][3] * rn * gg.w * sigm(hi16(ou[df].y));
      uint2 u; u.x = pack2(o0, o1); u.y = pack2(o2, o3);
      *(uint2*)(y + (size_t)orow * 1024 + 256 + h * 128 + d) = u;
    }
  }
  __syncthreads();
}

__device__ void rg_tile(unsigned char* lds, const Params& p, int l, int b, int ck, int hh, bool outmode) {
  float* XR = (float*)lds;
  bf16_t* XB = (bf16_t*)(XR + 64 * 65);
  bf16_t* WT = XB + 64 * 72;
  float* AA = (float*)(WT + 256 * 72);
  float* BQ = AA + 2 * 64 * 64;
  const int tid = opaque_tid(), lane = tid & 63, w = tid >> 6, lr = lane & 15, lg = lane >> 4;
  const bf16_t* z = (const bf16_t*)(p.ws + OFF_A);
  bf16_t* y = (bf16_t*)(p.ws + OFF_ACT);
  float* agg = (float*)(p.ws + OFF_RGAGG);
  const float* car = (const float*)(p.ws + OFF_RGCAR);
  const bool isctx = ck < 4;
  const int L = isctx ? 256 : 2048;
  const int t0 = isctx ? ck * 64 : (ck - 4) * 64;
  const int rowbase = isctx ? (NLAT + b * 256) : (b * 2048);
  float car_pre = 0.f, gp_pre[8];
  {
    const int d_ = (tid >> 6) & 1, j_ = tid & 63;
    if (outmode) {
      car_pre = car[((size_t)(b * 36 + ck) * 2 + d_) * 256 + hh * 64 + j_];
#pragma unroll
      for (int q = 0; q < 8; ++q) gp_pre[q] = bf2f(z[(size_t)(rowbase + t0 + w * 8 + q) * ZS + 2816 + 256 + hh * 64 + lane]);
    } else {
#pragma unroll
      for (int q = 0; q < 8; ++q) gp_pre[q] = 0.f;
    }
  }
  const int chm_ = hh * 64 + (w & 3) * 16 + lr, dm_ = w >> 2;
  const float br = p.in[22][(size_t)l * 1024 + (dm_ * 2 + 0) * 256 + chm_];
  const float bi = p.in[22][(size_t)l * 1024 + (dm_ * 2 + 1) * 256 + chm_];
  const float lam_ = p.in[23][(size_t)l * 512 + dm_ * 256 + chm_];
  {
    const int i = tid & 63, tq = tid >> 6;
    const int ch = hh * 64 + i;
    const float* wc = p.in[20] + (size_t)l * 4 * 256 + ch;
    const float w0 = wc[0], w1 = wc[256], w2 = wc[512], w3 = wc[768];
#pragma unroll
    for (int ii = 0; ii < 8; ++ii) {
      const int tt = tq * 8 + ii;
      const int tp = t0 + tt;
      const int tm1 = tp - 1 >= 0 ? tp - 1 : 0, tp1 = tp + 1 < L ? tp + 1 : L - 1, tp2 = tp + 2 < L ? tp + 2 : L - 1;
      const float z0 = bf2f(z[(size_t)(rowbase + tm1) * ZS + 2816 + ch]);
      const float z1 = bf2f(z[(size_t)(rowbase + tp) * ZS + 2816 + ch]);
      const float z2 = bf2f(z[(size_t)(rowbase + tp1) * ZS + 2816 + ch]);
      const float z3 = bf2f(z[(size_t)(rowbase + tp2) * ZS + 2816 + ch]);
      float xr = w1 * z1;
      xr += (tp - 1 >= 0 ? w0 : 0.f) * z0;
      xr += (tp + 1 < L ? w2 : 0.f) * z2;
      xr += (tp + 2 < L ? w3 : 0.f) * z3;
      XR[tt * 65 + i] = xr;
      XB[tt * 72 + i] = f2bf(xr);
    }
    const bf16_t* rgw = (const bf16_t*)(p.ws + OFF_RGW);
#pragma unroll
    for (int q = 0; q < 4; ++q) {
      const int id = tid + 512 * q;
      const int row = id >> 3, kc = id & 7;
      *(uint4*)(WT + row * 72 + kc * 8) = *(const uint4*)(rgw + ((size_t)((l * 4 + (row >> 6)) * 4 + hh)) * 4096 + (row & 63) * 64 + kc * 8);
    }
  }
  __syncthreads();
  {
    const int d = w >> 2, jf = w & 3;
    f32x4 ar[4], ai[4];
#pragma unroll
    for (int i = 0; i < 4; ++i) { ar[i] = (f32x4){0.f, 0.f, 0.f, 0.f}; ai[i] = (f32x4){0.f, 0.f, 0.f, 0.f}; }
#pragma unroll
    for (int ks = 0; ks < 2; ++ks) {
      const bf16x8 wr = ldfrag(WT + ((d * 2 + 0) * 64 + jf * 16 + lr) * 72 + ks * 32 + lg * 8);
      const bf16x8 wi = ldfrag(WT + ((d * 2 + 1) * 64 + jf * 16 + lr) * 72 + ks * 32 + lg * 8);
#pragma unroll
      for (int tf = 0; tf < 4; ++tf) {
        const bf16x8 xf = ldfrag(XB + (tf * 16 + lr) * 72 + ks * 32 + lg * 8);
        ar[tf] = mfma16(xf, wr, ar[tf]);
        ai[tf] = mfma16(xf, wi, ai[tf]);
      }
    }
    const int j = jf * 16 + lr;
    const int ch = hh * 64 + j;
    const float sp = softplusf(-lam_);
#pragma unroll
    for (int tf = 0; tf < 4; ++tf)
#pragma unroll
      for (int jj = 0; jj < 4; ++jj) {
        const int tt = tf * 16 + lg * 4 + jj;
        const float r = sigm(ar[tf][jj] + br);
        const float ig = sigm(ai[tf][jj] + bi);
        const float la = -8.0f * r * sp;
        const float a = fexp(la);
        const float bq = __builtin_amdgcn_sqrtf(fmaxf(1.f - a * a, 0.f)) * ig * XR[tt * 65 + j];
        AA[(d * 64 + tt) * 64 + j] = a;
        BQ[(d * 64 + tt) * 64 + j] = bq;
      }
  }
  __syncthreads();
  {
    float* SEG = XR;
    const int seg = tid >> 7, d = (tid >> 6) & 1, j = tid & 63;
    const int ch = hh * 64 + j;
    const size_t ci = ((size_t)(b * 36 + ck) * 2 + d) * 256 + ch;
    float H = 0.f, Ap = 1.f;
#pragma unroll
    for (int q = 0; q < 16; ++q) {
      const int pos = seg * 16 + q;
      const int tt = d == 0 ? pos : 63 - pos;
      const float a = AA[(d * 64 + tt) * 64 + j];
      H = a * H + BQ[(d * 64 + tt) * 64 + j];
      Ap *= a;
    }
    SEG[((seg * 2 + d) * 64 + j) * 2 + 0] = Ap;
    SEG[((seg * 2 + d) * 64 + j) * 2 + 1] = H;
    __syncthreads();
    if (!outmode) {
      if (seg == 0) {
        float Ht = 0.f, At = 1.f;
#pragma unroll
        for (int sgi = 0; sgi < 4; ++sgi) {
          const float as = SEG[((sgi * 2 + d) * 64 + j) * 2 + 0], hs = SEG[((sgi * 2 + d) * 64 + j) * 2 + 1];
          Ht = as * Ht + hs;
          At *= as;
        }
        agg[ci * 2 + 0] = At;
        agg[ci * 2 + 1] = Ht;
      }
    } else {
      float hc = car_pre;
      for (int sgi = 0; sgi < seg; ++sgi) {
        const float as = SEG[((sgi * 2 + d) * 64 + j) * 2 + 0], hs = SEG[((sgi * 2 + d) * 64 + j) * 2 + 1];
        hc = as * hc + hs;
      }
#pragma unroll
      for (int q = 0; q < 16; ++q) {
        const int pos = seg * 16 + q;
        const int tt = d == 0 ? pos : 63 - pos;
        const float a = AA[(d * 64 + tt) * 64 + j];
        hc = a * hc + BQ[(d * 64 + tt) * 64 + j];
        AA[(d * 64 + tt) * 64 + j] = hc;
      }
    }
  }
  __syncthreads();
  if (outmode) {
    const int ch = hh * 64 + lane;
    const float gm = p.in[24][(size_t)l * 1024 + 768 + ch];
#pragma unroll
    for (int q = 0; q < 8; ++q) {
      const int tt = w * 8 + q;
      const int row = rowbase + t0 + tt;
      const float hr = AA[tt * 64 + lane] + AA[(64 + tt) * 64 + lane];
      const float v = hr * gelu_tanh(gp_pre[q]);
      const float ss = wsum(v * v, lane);
      const float rn = rsqrtf(ss * (1.f / 64.f) + EPSF);
      y[(size_t)row * 1024 + 768 + ch] = f2bf(v * rn * gm);
    }
    __syncthreads();
  }
}

__device__ void rg_scan_phase(const Params& p) {
  const float* agg = (const float*)(p.ws + OFF_RGAGG);
  float* car = (float*)(p.ws + OFF_RGCAR);
  for (int tile = blockIdx.x; tile < 8; tile += gridDim.x) {
    const int gid = tile * 512 + opaque_tid();
    const int b = gid >> 9, d = (gid >> 8) & 1, ch = gid & 255;
    float2 ag[36];
#pragma unroll
    for (int i = 0; i < 36; ++i) {
      const int ck = (d == 0) ? i : (i < 4 ? 3 - i : 39 - i);
      const size_t ci = ((size_t)(b * 36 + ck) * 2 + d) * 256 + ch;
      ag[i] = *(const float2*)(agg + ci * 2);
    }
    float hcur = 0.f;
#pragma unroll
    for (int i = 0; i < 36; ++i) {
      const int ck = (d == 0) ? i : (i < 4 ? 3 - i : 39 - i);
      const size_t ci = ((size_t)(b * 36 + ck) * 2 + d) * 256 + ch;
      car[ci] = hcur;
      hcur = ag[i].x * hcur + ag[i].y;
    }
  }
}

__device__ void hy_prep_tile(unsigned char* lds, const Params& p, int l, int b, int ck) {
  bf16_t* uL = (bf16_t*)lds;
  const int tid = opaque_tid();
  const bf16_t* z = (const bf16_t*)(p.ws + OFF_A);
  bf16_t* uT = (bf16_t*)(p.ws + OFF_ACT);
  const bool isctx = ck < 4;
  const int L = isctx ? 256 : 2048;
  const int t0 = isctx ? ck * 64 : (ck - 4) * 64;
  const int rowbase = isctx ? (NLAT + b * 256) : (b * 2048);
  const int posoff = isctx ? 2048 : 0;
  {
    const int c = tid & 255, half = tid >> 8;
    const float* wc = p.in[9] + (size_t)l * 3 * 768;
    const float a0 = wc[256 + c], a1 = wc[768 + 256 + c], a2 = wc[1536 + 256 + c];
    const float v0 = wc[512 + c], v1 = wc[768 + 512 + c], v2 = wc[1536 + 512 + c];
    const int ts = t0 + half * 32;
    float xp, xc, xn, vp, vc, vn;
    { const int tq = ts - 1 >= 0 ? ts - 1 : 0; const float mk = ts - 1 >= 0 ? 1.f : 0.f;
      xp = mk * bf2f(z[(size_t)(rowbase + tq) * ZS + 256 + c]); vp = mk * bf2f(z[(size_t)(rowbase + tq) * ZS + 512 + c]); }
    xc = bf2f(z[(size_t)(rowbase + ts) * ZS + 256 + c]); vc = bf2f(z[(size_t)(rowbase + ts) * ZS + 512 + c]);
#pragma unroll 8
    for (int q = 0; q < 32; ++q) {
      const int tp = ts + q;
      { const int tq = tp + 1 < L ? tp + 1 : L - 1; const float mk = tp + 1 < L ? 1.f : 0.f;
        xn = mk * bf2f(z[(size_t)(rowbase + tq) * ZS + 256 + c]); vn = mk * bf2f(z[(size_t)(rowbase + tq) * ZS + 512 + c]); }
      const float x1 = a0 * xp + a1 * xc + a2 * xn;
      const float vv = v0 * vp + v1 * vc + v2 * vn;
      uL[c * 66 + half * 32 + q] = f2bf(x1 * vv);
      xp = xc; xc = xn; vp = vc; vc = vn;
    }
  }
  __syncthreads();
  {
    const int c = tid >> 1, hf = tid & 1;
    const unsigned* src = (const unsigned*)(uL + c * 66 + hf * 32);
    uint4* dst = (uint4*)(uT + ((size_t)c * 8 + b) * LTOT + posoff + t0 + hf * 32);
#pragma unroll
    for (int q = 0; q < 4; ++q) {
      uint4 u; u.x = src[q * 4 + 0]; u.y = src[q * 4 + 1]; u.z = src[q * 4 + 2]; u.w = src[q * 4 + 3];
      dst[q] = u;
    }
  }
  __syncthreads();
}

#define HY_OFF 2064
#define HY_CL 4128
__device__ void hy_conv_sub(unsigned char* lds, const Params& p, int l, int c, int L, int posoff) {
  bf16_t* cp = (bf16_t*)lds;
  bf16_t* uL = cp + 8 * HY_CL;
  const int tid = opaque_tid(), lane = tid & 63, w = tid >> 6, lr = lane & 15, lg = lane >> 4;
  const float* hf = (const float*)(p.ws + OFF_FILT) + ((size_t)(l * 256 + c) * 2 + 0) * LTOT + posoff;
  const float* hb = hf + LTOT;
  const bf16_t* uT = (const bf16_t*)(p.ws + OFF_ACT);
  bf16_t* ycv = (bf16_t*)(p.ws + OFF_YCV);
#pragma unroll 8
  for (int idx = tid; idx < 8 * HY_CL; idx += 512) {
    const int cc = idx / HY_CL, m = idx - cc * HY_CL;
    const int n = m - cc - HY_OFF;
    const int a = n <= 0 ? -n : n;
    const int ac = a < L ? a : L - 1;
    const float* base = (n <= 0) ? hf : hb;
    const float v = base[ac];
    cp[idx] = f2bf(a < L ? v : 0.f);
  }
  for (int idx = tid; idx < 8 * (L >> 3); idx += 512) {
    const int bb = idx / (L >> 3), q = idx - bb * (L >> 3);
    *(uint4*)(uL + bb * 2048 + q * 8) = *(const uint4*)(uT + ((size_t)c * 8 + bb) * LTOT + posoff + q * 8);
  }
  __syncthreads();
  const float bias = p.in[17][l * 256 + c];
  const int ngroups = L >> 7, ksteps = L >> 5;
  for (int g = w; g < ngroups; g += 8) {
    f32x4 acc[8];
#pragma unroll
    for (int i = 0; i < 8; ++i) acc[i] = (f32x4){0.f, 0.f, 0.f, 0.f};
    const bf16_t* abase = cp + (lr & 7) * HY_CL + HY_OFF + 8 * lg - 8 * (lr >> 3) - 128 * g;
    const bf16_t* bbase = uL + (lr & 7) * 2048 + lg * 8;
    bf16x8 a[8];
#pragma unroll
    for (int mi = 2; mi < 8; ++mi) a[(-mi) & 7] = ldfrag(abase - 16 * mi);
    for (int ks4 = 0; ks4 < ksteps; ks4 += 4) {
#pragma unroll
      for (int j = 0; j < 4; ++j) {
        const int ks = ks4 + j;
        a[(2 * j) & 7] = ldfrag(abase + ks * 32);
        a[(2 * j - 1) & 7] = ldfrag(abase + ks * 32 - 16);
        const bf16x8 bfr = ldfrag(bbase + ks * 32);
#pragma unroll
        for (int mi = 0; mi < 8; ++mi) acc[mi] = mfma16(a[(2 * j - mi) & 7], bfr, acc[mi]);
      }
    }
    if (lr < 8) {
#pragma unroll
      for (int mi = 0; mi < 8; ++mi) {
        const int tb = 128 * g + 16 * mi + 4 * lg;
        float o[4];
#pragma unroll
        for (int j = 0; j < 4; ++j) o[j] = acc[mi][j] + bf2f(uL[lr * 2048 + tb + j]) * bias;
        uint2 u; u.x = pack2(o[0], o[1]); u.y = pack2(o[2], o[3]);
        *(uint2*)(ycv + ((size_t)c * 8 + lr) * LTOT + posoff + tb) = u;
      }
    }
  }
  __syncthreads();
}

__device__ void hy_merge_tile(unsigned char* lds, const Params& p, int l, int b, int ck) {
  bf16_t* yL = (bf16_t*)lds;
  const int tid = opaque_tid(), lane = tid & 63, w = tid >> 6;
  const bf16_t* z = (const bf16_t*)(p.ws + OFF_A);
  const bf16_t* ycv = (const bf16_t*)(p.ws + OFF_YCV);
  bf16_t* y = (bf16_t*)(p.ws + OFF_ACT);
  const bool isctx = ck < 4;
  const int L = isctx ? 256 : 2048;
  const int t0 = isctx ? ck * 64 : (ck - 4) * 64;
  const int rowbase = isctx ? (NLAT + b * 256) : (b * 2048);
  const int posoff = isctx ? 2048 : 0;
#pragma unroll
  for (int i = 0; i < 4; ++i) {
    const int id = tid + 512 * i;
    const int c = id >> 3, q = id & 7;
    *(uint4*)(yL + c * 72 + q * 8) = *(const uint4*)(ycv + ((size_t)c * 8 + b) * LTOT + posoff + t0 + q * 8);
  }
  __syncthreads();
  const float* wc = p.in[9] + (size_t)l * 3 * 768;
  const float* gm = p.in[24] + (size_t)l * 1024;
#pragma unroll 4
  for (int q = 0; q < 8; ++q) {
    const int tt = w + 8 * q;
    const int tp = t0 + tt;
#pragma unroll
    for (int gi = 0; gi < 4; ++gi) {
      const int c = gi * 64 + lane;
      const int tm1 = tp - 1 >= 0 ? tp - 1 : 0, tp1 = tp + 1 < L ? tp + 1 : L - 1;
      const float za = bf2f(z[(size_t)(rowbase + tm1) * ZS + c]);
      const float zb = bf2f(z[(size_t)(rowbase + tp) * ZS + c]);
      const float zc = bf2f(z[(size_t)(rowbase + tp1) * ZS + c]);
      float x0 = wc[768 + c] * zb;
      x0 += (tp - 1 >= 0 ? wc[c] : 0.f) * za;
      x0 += (tp + 1 < L ? wc[1536 + c] : 0.f) * zc;
      const float v = x0 * bf2f(yL[c * 72 + tt]);
      const float ss = wsum(v * v, lane);
      const float rn = rsqrtf(ss * (1.f / 64.f) + EPSF);
      y[(size_t)(rowbase + tp) * 1024 + c] = f2bf(v * rn * gm[c]);
    }
  }
  __syncthreads();
}

__global__ void __launch_bounds__(512) fwd_kernel(Params p) {
  extern __shared__ __attribute__((aligned(16))) unsigned char lds[];
  cg::grid_group grid = cg::this_grid();
  const int G_ = gridDim.x;
  if (threadIdx.x == 0) *(uint4*)(lds + LDS_XB) = make_uint4(0u, 0u, 0u, 0u);
  __syncthreads();
  XcdBarrier xb = xcd_barrier_post((unsigned*)(p.ws + OFF_BAR), (volatile LAS unsigned*)(lds + LDS_XB));
  unsigned char* ws = p.ws;
  bf16_t* act = (bf16_t*)(ws + OFF_ACT);
  bf16_t* zbuf = (bf16_t*)(ws + OFF_A);
  bf16_t* hid_lat = (bf16_t*)(ws + OFF_A);
  bf16_t* hid_ctx = (bf16_t*)(ws + OFF_ST);
  float* ctxs = (float*)(ws + OFF_CTXS);
  float* cpart = (float*)(ws + OFF_ST + 16 * MiB);
  const float* modall = (const float*)(ws + OFF_MOD);

  mods_phase(lds, p);
  if (p.ws == nullptr) grid.sync();
  GSYNC();

#pragma unroll 1
  for (int l = 0; l < 2; ++l) {
    const bool need_ctx = (l == 0);
    const float* xin = (l == 0) ? p.in[0] : p.out;
    const float* cin = (l == 0) ? p.in[2] : ctxs;
    const float* modl = modall + (size_t)l * 9 * 6144;
    norm_phase<3, true>(lds, p, l, xin, cin, (l == 1) ? cpart : nullptr, p.in[6] + l * 1024, 0, NROW);
    if (l == 1 && G_ != 256) convert_w1_w2(lds, p, 1, blockIdx.x, G_);
    if (l == 0) {
      for (int rep = 0; rep < REP_P0; ++rep) {
        convert_win_wout(lds, p, 0, blockIdx.x, G_);
        if (G_ <= 64) convert_w1_w2(lds, p, 0, blockIdx.x, G_);
        filters_phase(lds, p);
        rgw_phase(p);
      }
    }
    GSYNC();
    for (int rep = 0; rep < REP_P2; ++rep)
    gemm_phase(lds, act, act + (size_t)NLAT * 1024, 1024, (const bf16_t*)(ws + OFF_WIN), 1024, 72, 13, 1,
               [=](int m, int n, f32x4 v, f32x4 w, int) {
                 uint4 u; u.x = pack2(v[0], v[1]); u.y = pack2(v[2], v[3]); u.z = pack2(w[0], w[1]); u.w = pack2(w[2], w[3]);
                 *(uint4*)(zbuf + (size_t)m * ZS + n) = u;
               });
    if (l == 1 && G_ == 256 && (int)blockIdx.x >= 168) convert_w1_w2(lds, p, 1, (int)blockIdx.x - 168, 88, 1024);
    GSYNC();
    for (int rep = 0; rep < REP_P3; ++rep) {
    for (int item = blockIdx.x; item < 576 + 1152 + 288; item += G_) {
      if (item < 576) {
        const int n = item % 18, bh = item / 18;
        ml_local_tile(lds, p, l, bh >> 2, bh & 3, n);
      } else if (item < 576 + 1152) {
        const int tile = item - 576;
        const int hh = tile & 3, ck = (tile >> 2) % 36, b = tile / 144;
        rg_tile(lds, p, l, b, ck, hh, false);
      } else {
        const int tile = item - 576 - 1152;
        hy_prep_tile(lds, p, l, tile / 36, tile % 36);
      }
    }
    }
    if (l == 1 && G_ == 256 && (int)blockIdx.x >= 64) convert_w1_w2(lds, p, 1, 1024 + (int)blockIdx.x - 64, 192, 2048);
    GSYNC();
    for (int rep = 0; rep < REP_HYC; ++rep)
    for (int c = blockIdx.x; c < 256; c += G_) {
      hy_conv_sub(lds, p, l, c, 2048, 0);
      if (need_ctx) hy_conv_sub(lds, p, l, c, 256, 2048);
    }
    ml_scan_phase(p);
    rg_scan_phase(p);
    GSYNC();
    {
      const int nfirst = need_ctx ? 0 : 2, ncnt = 18 - nfirst;
      const int cfirst = need_ctx ? 0 : 4, ccnt = 36 - cfirst;
      const int n_ml = 32 * ncnt, n_rg = 32 * ccnt, n_hy = 8 * ccnt;
      for (int item0 = blockIdx.x; item0 < REP_P5 * (REP_ML * n_ml + REP_RG * n_rg + n_hy); item0 += G_) {
        int item = (REP_P5 > 1) ? item0 % (n_ml + n_rg + n_hy) : item0;
        if (REP_ML > 1) item = (item0 < REP_ML * n_ml) ? item0 % n_ml : item0 - (REP_ML - 1) * n_ml;
        if (REP_RG > 1) item = (item0 < n_ml) ? item0 : ((item0 < n_ml + REP_RG * n_rg) ? n_ml + (item0 - n_ml) % n_rg : item0 - (REP_RG - 1) * n_rg);
        if (item < n_ml) {
          const int n = nfirst + item % ncnt, bh = item / ncnt;
          ml_out_tile(lds, p, l, bh >> 2, bh & 3, n);
        } else if (item < n_ml + n_rg) {
          const int tile = item - n_ml;
          const int hh = tile & 3, ck = cfirst + (tile >> 2) % ccnt, b = tile / (4 * ccnt);
          rg_tile(lds, p, l, b, ck, hh, true);
        } else {
          const int tile = item - n_ml - n_rg;
          hy_merge_tile(lds, p, l, tile / ccnt, cfirst + tile % ccnt);
        }
      }
      if (l == 0 && G_ > 64 && (int)blockIdx.x >= 64) {
        if (G_ == 256) convert_w1_w2(lds, p, 0, (int)blockIdx.x - 64, 192, 1024);
        else convert_w1_w2(lds, p, 0, (int)blockIdx.x - 64, G_ - 64);
      }
    }
    GSYNC();
    const int mt_res = need_ctx ? 72 : 64;
    {
      const float* cres = cin;
      gemm_phase(lds, act, act + (size_t)NLAT * 1024, 1024, (const bf16_t*)(ws + OFF_WOUT), 1024, mt_res, 4, 1,
                 [=](int m, int n, f32x4 v, f32x4 w, int) {
                   const float* src; float* dst; const float* g;
                   if (m < NLAT) { src = xin + (size_t)m * 1024 + n; dst = p.out + (size_t)m * 1024 + n; g = modl + (size_t)(m >> 11) * 6144 + 2 * 1024 + n; }
                   else { src = cres + (size_t)(m - NLAT) * 1024 + n; dst = ctxs + (size_t)(m - NLAT) * 1024 + n; g = modl + (size_t)8 * 6144 + 2 * 1024 + n; }
                   const float4 s4 = *(const float4*)src; const float4 g4 = *(const float4*)g;
                   const float4 s5 = *(const float4*)(src + 4); const float4 g5 = *(const float4*)(g + 4);
                   float4 o; o.x = s4.x + g4.x * v[0]; o.y = s4.y + g4.y * v[1]; o.z = s4.z + g4.z * v[2]; o.w = s4.w + g4.w * v[3];
                   float4 o2; o2.x = s5.x + g5.x * w[0]; o2.y = s5.y + g5.y * w[1]; o2.z = s5.z + g5.z * w[2]; o2.w = s5.w + g5.w * w[3];
                   *(float4*)dst = o; *(float4*)(dst + 4) = o2;
                 });
    }
    if (l == 0 && G_ == 256 && (int)blockIdx.x >= 32) convert_w1_w2(lds, p, 0, 1024 + (int)blockIdx.x - 32, 224, 2048);
    GSYNC();
    if (need_ctx) norm_phase<3, false>(lds, p, l, p.out, ctxs, nullptr, p.in[7] + l * 1024, 3, NROW);
    else norm_phase<4, false>(lds, p, l, p.out, ctxs, nullptr, p.in[7] + l * 1024, 3, NLAT);
    if (l == 0 && G_ != 256) convert_win_wout(lds, p, 1, blockIdx.x, G_);
    GSYNC();
    for (int rep = 0; rep < REP_P8; ++rep)
    gemm_phase(lds, act, act + (size_t)NLAT * 1024, 1024, (const bf16_t*)(ws + OFF_W1), 1024, mt_res, 16, 1,
               [=](int m, int n, f32x4 v, f32x4 w, int) {
                 float r0 = fmaxf(v[0], 0.f), r1 = fmaxf(v[1], 0.f), r2 = fmaxf(v[2], 0.f), r3 = fmaxf(v[3], 0.f);
                 float r4 = fmaxf(w[0], 0.f), r5 = fmaxf(w[1], 0.f), r6 = fmaxf(w[2], 0.f), r7 = fmaxf(w[3], 0.f);
                 uint4 u; u.x = pack2(r0 * r0, r1 * r1); u.y = pack2(r2 * r2, r3 * r3); u.z = pack2(r4 * r4, r5 * r5); u.w = pack2(r6 * r6, r7 * r7);
                 bf16_t* dst = (m < NLAT) ? (hid_lat + (size_t)m * 4096 + n) : (hid_ctx + (size_t)(m - NLAT) * 4096 + n);
                 *(uint4*)dst = u;
               });
    if (l == 0 && G_ == 256 && (int)blockIdx.x >= 128) convert_win_wout(lds, p, 1, (int)blockIdx.x - 128, 128);
    GSYNC();
    gemm_phase(lds, hid_lat, hid_ctx, 4096, (const bf16_t*)(ws + OFF_W2), 4096, mt_res, 4, 3,
               [=](int m, int n, f32x4 v, f32x4 w, int piece) {
                 float* dst; const float* g;
                 if (m < NLAT) { dst = p.out + (size_t)m * 1024 + n; g = modl + (size_t)(m >> 11) * 6144 + 5 * 1024 + n; }
                 else { dst = ((piece == 0) ? ctxs : (cpart + (size_t)(piece - 1) * 2048 * 1024)) + (size_t)(m - NLAT) * 1024 + n; g = modl + (size_t)8 * 6144 + 5 * 1024 + n; }
                 const float4 g4 = *(const float4*)g; const float4 g5 = *(const float4*)(g + 4);
                 float4 o; o.x = g4.x * v[0]; o.y = g4.y * v[1]; o.z = g4.z * v[2]; o.w = g4.w * v[3];
                 float4 o2; o2.x = g5.x * w[0]; o2.y = g5.y * w[1]; o2.z = g5.z * w[2]; o2.w = g5.w * w[3];
                 if (piece == 0) {
                   const float4 s4 = *(const float4*)dst; const float4 s5 = *(const float4*)(dst + 4);
                   o.x += s4.x; o.y += s4.y; o.z += s4.z; o.w += s4.w; o2.x += s5.x; o2.y += s5.y; o2.z += s5.z; o2.w += s5.w;
                 }
                 *(float4*)dst = o; *(float4*)(dst + 4) = o2;
               });
    GSYNC();
  }
  final_norm_phase(p);
}

extern "C" void kernel_launch(void* const* d_in, const int* in_sizes, int n_in, void* d_out, int out_size, void* d_ws,
                              size_t ws_size, hipStream_t stream) {
  static int grid_blocks = 0;
  if (!grid_blocks) {
    int dev = 0, cus = 0, per_cu = 0;
    hipGetDevice(&dev);
    hipDeviceGetAttribute(&cus, hipDeviceAttributeMultiprocessorCount, dev);
    hipFuncSetAttribute((const void*)fwd_kernel, hipFuncAttributeMaxDynamicSharedMemorySize, LDS_BYTES);
    hipOccupancyMaxActiveBlocksPerMultiprocessor(&per_cu, (const void*)fwd_kernel, 512, LDS_BYTES);
    if (per_cu < 1) { fprintf(stderr, "occupancy query returned %d\n", per_cu); per_cu = 1; }
    if (per_cu > 1) per_cu = 1;
    grid_blocks = cus * per_cu;
    if (ws_size < OFF_END) fprintf(stderr, "workspace too small: %zu < %zu\n", ws_size, (size_t)OFF_END);
  }
  hipMemsetAsync((unsigned char*)d_ws + OFF_BAR, 0, XCD_BAR_WORDS * 4, stream);
  Params p{};
  for (int i = 0; i < 29; ++i) p.in[i] = (const float*)d_in[i];
  p.out = (float*)d_out;
  p.ws = (unsigned char*)d_ws;
  void* args[] = {&p};
  hipError_t e = hipLaunchCooperativeKernel((const void*)fwd_kernel, dim3(grid_blocks), dim3(512), args, LDS_BYTES, stream);
  if (e != hipSuccess) fprintf(stderr, "cooperative launch failed: %s (grid %d)\n", hipGetErrorString(e), grid_blocks);
}
```
